# Optimizing an MI355X kernel written in HIP

```python
import math
import jax
import jax.numpy as jnp
from jax import lax
import numpy as np

D_MODEL = 1024
BATCH = 16
SEQ = 256
DEPTH = 2
DEC_BATCH = 4
DEC_SEQ = 4096
PAST_LEN = 256

GRID_W = 64
HEAD_DIM = 64
N_DIR = 2
ATT_WIDTH = 3 * D_MODEL // 8
ATT_HEADS = ATT_WIDTH // HEAD_DIM
ATT_KV_HEADS = 2
ATT_GROUP = ATT_HEADS // ATT_KV_HEADS
KV_WIDTH = ATT_KV_HEADS * HEAD_DIM
WINDOW = 128
ATT_BLOCK = 128
ATT_SCALE = HEAD_DIM ** -0.5
ROPE_BASE = 10000.0
SSD_WIDTH = 3 * D_MODEL // 8
SSD_HEADS = SSD_WIDTH // HEAD_DIM
SSD_STATE = 64
SSD_GROUPS = 2
SSD_CONV = 5
SSD_CHUNK = 128
SSD_CONV_CH = SSD_WIDTH + 2 * SSD_GROUPS * SSD_STATE
RWKV_WIDTH = D_MODEL // 4
RWKV_HEADS = RWKV_WIDTH // HEAD_DIM
RWKV_W_RANK = 64
RWKV_A_RANK = 64
RWKV_G_RANK = 128
RWKV_COLS = 3 * RWKV_WIDTH + RWKV_W_RANK + RWKV_A_RANK + RWKV_G_RANK
RWKV_GN_EPS = 64e-5
RWKV_SPLITS = (RWKV_WIDTH, 2 * RWKV_WIDTH, 3 * RWKV_WIDTH, 3 * RWKV_WIDTH + RWKV_W_RANK, 3 * RWKV_WIDTH + RWKV_W_RANK + RWKV_A_RANK)
IN_SIZES = (ATT_WIDTH, KV_WIDTH, KV_WIDTH, SSD_WIDTH, SSD_CONV_CH, N_DIR * SSD_HEADS, RWKV_COLS)
IN_COLS = sum(IN_SIZES)
IN_SPLITS = tuple(sum(IN_SIZES[:i + 1]) for i in range(len(IN_SIZES) - 1))
FFN_HIDDEN = -(-8 * D_MODEL // (3 * 256)) * 256
DEEPNORM_ALPHA = (2 * DEPTH) ** 0.25
DEEPNORM_BETA = (8 * DEPTH) ** -0.25
LN_EPS = 1e-5

kernel_name = 'hybrid_flow_backbone_step'


def layer_norm(x, w, b):
    xf = x.astype(jnp.float32)
    mu = jnp.mean(xf, -1, keepdims=True)
    var = jnp.mean(jnp.square(xf - mu), -1, keepdims=True)
    return ((xf - mu) * lax.rsqrt(var + LN_EPS)).astype(x.dtype) * w + b


def adaln_modulation(cond, w_mod, b_mod):
    return (jax.nn.silu(cond) @ w_mod + b_mod)[:, None, :]


def two_way(t):
    return jnp.stack([t, t[:, ::-1]])


def orient(t):
    return jnp.stack([t[0], t[1][:, ::-1]])


def axial_rope(x):
    T = x.shape[1]
    rows = T // GRID_W
    row = jnp.repeat(jnp.arange(rows), GRID_W).astype(jnp.float32)
    col = jnp.tile(jnp.arange(GRID_W), rows).astype(jnp.float32)
    half = HEAD_DIM // 2
    inv_freq = 1.0 / (ROPE_BASE ** (jnp.arange(0, half, 2, dtype=jnp.float32) / half))

    def rotate(xa, pos):
        ang = pos[:, None] * inv_freq[None, :]
        cos = jnp.cos(ang)[None, :, None, :].astype(x.dtype)
        sin = jnp.sin(ang)[None, :, None, :].astype(x.dtype)
        x1, x2 = xa[..., : half // 2], xa[..., half // 2:]
        return jnp.concatenate([x1 * cos - x2 * sin, x2 * cos + x1 * sin], axis=-1)

    return jnp.concatenate([rotate(x[..., :half], row), rotate(x[..., half:], col)], axis=-1)


def context_attention(q, k, v, sink):
    B, S = q.shape[:2]
    nb = S // ATT_BLOCK
    qb = jnp.moveaxis(q.reshape(B, nb, ATT_BLOCK, ATT_KV_HEADS, ATT_GROUP, HEAD_DIM), 1, 0)
    sink_f = sink.astype(jnp.float32).reshape(1, ATT_KV_HEADS, ATT_GROUP, 1)
    vf = v.astype(jnp.float32)

    def one_block(qblk):
        s = jnp.einsum('bqhgd,bkhd->bhgqk', qblk, k, preferred_element_type=jnp.float32) * ATT_SCALE
        m = jnp.maximum(jnp.max(s, -1), sink_f)
        p = jnp.exp(s - m[..., None])
        den = jnp.sum(p, -1) + jnp.exp(sink_f - m)
        o = jnp.einsum('bhgqk,bkhd->bhgqd', p, vf) / den[..., None]
        return o.transpose(0, 3, 1, 2, 4)

    o = lax.map(one_block, qb)
    return jnp.moveaxis(o, 0, 1).reshape(B, S, ATT_WIDTH).astype(q.dtype)


def latent_attention(q, k, v, k_ctx, v_ctx, sink):
    B, T = q.shape[:2]
    nb = T // ATT_BLOCK
    qb = q.reshape(B, nb, ATT_BLOCK, ATT_KV_HEADS, ATT_GROUP, HEAD_DIM)

    def band(t):
        tp = jnp.pad(t, ((0, 0), (ATT_BLOCK, ATT_BLOCK), (0, 0), (0, 0)))
        tp = tp.reshape(B, nb + 2, ATT_BLOCK, ATT_KV_HEADS, HEAD_DIM)
        return jnp.concatenate([tp[:, :-2], tp[:, 1:-1], tp[:, 2:]], axis=2)

    kb, vb = band(k), band(v)
    blk = jnp.arange(nb)[:, None] * ATT_BLOCK
    q_pos = blk + jnp.arange(ATT_BLOCK)[None, :]
    k_pos = blk - ATT_BLOCK + jnp.arange(3 * ATT_BLOCK)[None, :]
    kp = k_pos[:, None, :]
    valid = (jnp.abs(q_pos[:, :, None] - kp) <= WINDOW) & (kp >= 0) & (kp < T)
    s_loc = jnp.einsum('bnqhgd,bnkhd->bnhgqk', qb, kb, preferred_element_type=jnp.float32) * ATT_SCALE
    s_loc = jnp.where(valid[None, :, None, None], s_loc, -jnp.inf)
    s_ctx = jnp.einsum('bnqhgd,bkhd->bnhgqk', qb, k_ctx, preferred_element_type=jnp.float32) * ATT_SCALE
    sink_f = sink.astype(jnp.float32).reshape(1, 1, ATT_KV_HEADS, ATT_GROUP, 1)
    m = jnp.maximum(jnp.maximum(jnp.max(s_loc, -1), jnp.max(s_ctx, -1)), sink_f)
    p_loc = jnp.exp(s_loc - m[..., None])
    p_ctx = jnp.exp(s_ctx - m[..., None])
    den = jnp.sum(p_loc, -1) + jnp.sum(p_ctx, -1) + jnp.exp(sink_f - m)
    o = (jnp.einsum('bnhgqk,bnkhd->bnhgqd', p_loc, vb.astype(jnp.float32))
         + jnp.einsum('bnhgqk,bkhd->bnhgqd', p_ctx, v_ctx.astype(jnp.float32))) / den[..., None]
    return o.transpose(0, 1, 4, 2, 3, 5).reshape(B, T, ATT_WIDTH).astype(q.dtype)


def centred_depthwise_conv(x, w, b):
    y = lax.conv_general_dilated(x, w[:, None, :].astype(x.dtype), window_strides=(1,),
                                 padding=[(SSD_CONV // 2, SSD_CONV // 2)],
                                 dimension_numbers=('NWC', 'WIO', 'NWC'),
                                 feature_group_count=x.shape[-1])
    return y + b


def segsum(a):
    L = a.shape[-1]
    cs = jnp.cumsum(a, axis=-1)
    diff = cs[..., :, None] - cs[..., None, :]
    return jnp.where(jnp.tril(jnp.ones((L, L), dtype=bool)), diff, -jnp.inf)


def ssd_chunked_scan(x, a, b, c, state0):
    B, T, H, P = x.shape
    nc = T // SSD_CHUNK
    x = x.reshape(B, nc, SSD_CHUNK, H, P)
    b = b.reshape(B, nc, SSD_CHUNK, H, -1)
    c = c.reshape(B, nc, SSD_CHUNK, H, -1)
    a = a.reshape(B, nc, SSD_CHUNK, H).transpose(0, 3, 1, 2)
    a_cum = jnp.cumsum(a, axis=-1)
    decay_in = jnp.exp(segsum(a))
    cb = jnp.einsum('bclhn,bcshn->bhcls', c, b)
    y_diag = jnp.einsum('bhcls,bcshp->bclhp', cb * decay_in, x)
    decay_to_end = jnp.exp(a_cum[..., -1:] - a_cum)
    chunk_states = jnp.einsum('bclhn,bhcl,bclhp->bchpn', b, decay_to_end, x)
    states = jnp.concatenate([state0[:, None], chunk_states], axis=1)
    chunk_decay = jnp.exp(segsum(jnp.pad(a_cum[..., -1], ((0, 0), (0, 0), (1, 0)))))
    states = jnp.einsum('bhzc,bchpn->bzhpn', chunk_decay, states)
    y_off = jnp.einsum('bclhn,bchpn,bhcl->bclhp', c, states[:, :-1], jnp.exp(a_cum))
    return (y_diag + y_off).reshape(B, T, H, P), states[:, -1]


def ssd_mixer(z, xbc, dt_raw, lp, state0):
    B, T, _ = z.shape
    f32 = jnp.float32
    xbc = jax.nn.silu(centred_depthwise_conv(xbc, lp['ssd_conv_w'], lp['ssd_conv_b'])).astype(f32)
    xs, bm, cm = jnp.split(xbc, [SSD_WIDTH, SSD_WIDTH + SSD_GROUPS * SSD_STATE], axis=-1)
    rep = SSD_HEADS // SSD_GROUPS
    xs = xs.reshape(B, T, SSD_HEADS, HEAD_DIM)
    bm = jnp.repeat(bm.reshape(B, T, SSD_GROUPS, SSD_STATE), rep, axis=2)
    cm = jnp.repeat(cm.reshape(B, T, SSD_GROUPS, SSD_STATE), rep, axis=2)
    dt = jnp.moveaxis(dt_raw.reshape(B, T, N_DIR, SSD_HEADS), 2, 0).astype(f32)
    dt = orient(jax.nn.softplus(dt + lp['ssd_dt_bias'][:, None, None, :].astype(f32)))
    a = -jnp.exp(lp['ssd_a_log'].astype(f32))
    x_s = two_way(xs) * dt[..., None]
    a_s = dt * a[:, None, None, :]
    y_s, fin = jax.vmap(ssd_chunked_scan)(x_s, a_s, two_way(bm), two_way(cm), state0.astype(f32))
    y = y_s[0] + y_s[1][:, ::-1] + lp['ssd_d'][:, None].astype(f32) * xs
    y = y.reshape(B, T, SSD_WIDTH) * jax.nn.silu(z.astype(f32))
    y = y * lax.rsqrt(jnp.mean(jnp.square(y), -1, keepdims=True) + LN_EPS) * lp['ssd_norm_w']
    return y.astype(z.dtype), fin


def bidir_token_shift(p):
    prev = jnp.pad(p, ((0, 0), (1, 0), (0, 0)))[:, :-1]
    nxt = jnp.pad(p, ((0, 0), (0, 1), (0, 0)))[:, 1:]
    return 0.5 * (prev + nxt)


def rwkv_mixer(p, lp, state0):
    B, T, _ = p.shape
    f32 = jnp.float32
    pf = p.astype(f32)
    pf = pf + lp['rwkv_mu'] * (bidir_token_shift(pf) - pf)
    r, k, v, wd, ad, gd = jnp.split(pf, RWKV_SPLITS, axis=-1)
    w_raw = lp['rwkv_w0'][:, None, None, :] + jnp.einsum('btr,drc->dbtc', jnp.tanh(wd), lp['rwkv_w_up'])
    decay = jnp.exp(-jnp.exp(-jax.nn.softplus(-w_raw) - 0.5))
    a = jax.nn.sigmoid(lp['rwkv_a0'][:, None, None, :] + jnp.einsum('btr,drc->dbtc', ad, lp['rwkv_a_up']))
    g = jax.nn.sigmoid(gd) @ lp['rwkv_g_up']

    def heads(t):
        return t.reshape(t.shape[:-1] + (RWKV_HEADS, HEAD_DIM))

    kk = heads(k * lp['rwkv_k_k'])
    kk = kk * lax.rsqrt(jnp.sum(kk * kk, -1, keepdims=True) + 1e-12)
    k_d = heads(k[None] * (1.0 + (a - 1.0) * lp['rwkv_k_a']))
    r_h, v_h = heads(r), heads(v)
    seq = (two_way(r_h), orient(heads(decay)), orient(k_d), two_way(v_h), two_way(kk), orient(heads(a)))
    seq = tuple(jnp.moveaxis(t, 2, 0) for t in seq)

    def step(S, inp):
        r_t, w_t, k_t, v_t, kk_t, a_t = inp
        sk = jnp.einsum('dbhvk,dbhk->dbhv', S, kk_t)
        S = (S * w_t[..., None, :] - sk[..., :, None] * (kk_t * a_t)[..., None, :]
             + v_t[..., :, None] * k_t[..., None, :])
        return S, jnp.einsum('dbhvk,dbhk->dbhv', S, r_t)

    fin, o = lax.scan(step, state0.astype(f32), seq)
    o = jnp.moveaxis(o, 0, 2)
    o = o[0] + o[1][:, ::-1]
    mu = jnp.mean(o, -1, keepdims=True)
    var = jnp.mean(jnp.square(o - mu), -1, keepdims=True)
    o = ((o - mu) * lax.rsqrt(var + RWKV_GN_EPS)).reshape(B, T, RWKV_WIDTH) * lp['rwkv_gn_w'] + lp['rwkv_gn_b']
    bonus = jnp.sum(jnp.sum(r_h[None] * k_d * lp['rwkv_r_k'], -1, keepdims=True), 0) * v_h
    y = (o + bonus.reshape(B, T, RWKV_WIDTH)) * g
    return y.astype(p.dtype), fin


def mixer_forward(h, lp, ctx_cache):
    B, T, _ = h.shape
    q, k, v, z, xbc, dt_raw, rw = jnp.split(h @ lp['w_in'], IN_SPLITS, axis=-1)
    q = q.reshape(B, T, ATT_HEADS, HEAD_DIM)
    k = k.reshape(B, T, ATT_KV_HEADS, HEAD_DIM)
    v = v.reshape(B, T, ATT_KV_HEADS, HEAD_DIM)
    if ctx_cache is None:
        att = context_attention(q, k, v, lp['attn_sink'])
        ssd0 = jnp.zeros((N_DIR, B, SSD_HEADS, HEAD_DIM, SSD_STATE), jnp.float32)
        rwkv0 = jnp.zeros((N_DIR, B, RWKV_HEADS, HEAD_DIM, HEAD_DIM), jnp.float32)
    else:
        k_ctx, v_ctx, ssd_ctx, rwkv_ctx = ctx_cache
        att = latent_attention(axial_rope(q), axial_rope(k), v, k_ctx, v_ctx, lp['attn_sink'])
        ssd0 = jnp.moveaxis(ssd_ctx, 1, 0)
        rwkv0 = jnp.moveaxis(rwkv_ctx, 1, 0)
    y_ssd, ssd_fin = ssd_mixer(z, xbc, dt_raw, lp, ssd0)
    y_rwkv, rwkv_fin = rwkv_mixer(rw, lp, rwkv0)
    out = jnp.concatenate([att, y_ssd, y_rwkv], axis=-1) @ lp['w_out']
    if ctx_cache is None:
        return out, (k, v, jnp.moveaxis(ssd_fin, 0, 1), jnp.moveaxis(rwkv_fin, 0, 1))
    return out, None


def swiglu_ffn(h, w_in, w_out):
    gate, up = jnp.split(h @ w_in, 2, axis=-1)
    return (jax.nn.silu(gate) * up) @ w_out


def trunk_layer(x, mod, lp, ctx_cache):
    shift1, scale1, gate1, shift2, scale2, gate2 = jnp.split(mod, 6, axis=-1)
    mix, ctx_tensors = mixer_forward(x * (1.0 + scale1) + shift1, lp, ctx_cache)
    x = layer_norm(DEEPNORM_ALPHA * x + gate1 * mix, lp['ln1_w'], lp['ln1_b'])
    ffn = swiglu_ffn(x * (1.0 + scale2) + shift2, lp['ffn_w_in'], lp['ffn_w_out'])
    x = layer_norm(DEEPNORM_ALPHA * x + gate2 * ffn, lp['ln2_w'], lp['ln2_b'])
    return x, ctx_tensors


def setup_inputs(seed: int = 0) -> dict:
    key = jax.random.key(seed)
    keys = iter(jax.random.split(key, 48))
    f32 = jnp.float32
    L = DEPTH

    def normal(shape, scale):
        return jax.random.normal(next(keys), shape, f32) * scale

    def uniform(shape, lo, hi):
        return jax.random.uniform(next(keys), shape, f32, lo, hi)

    dt0 = jnp.exp(uniform((L, N_DIR, SSD_HEADS), math.log(1e-3), math.log(1e-1)))
    return {
        'x_prompt': normal((BATCH, SEQ, D_MODEL), 1.0),
        'x_sample': normal((DEC_BATCH, DEC_SEQ, D_MODEL), 1.0),
        'cache_k': normal((DEC_BATCH, DEPTH, PAST_LEN, ATT_KV_HEADS, HEAD_DIM), 1.0),
        'cache_v': normal((DEC_BATCH, DEPTH, PAST_LEN, ATT_KV_HEADS, HEAD_DIM), 1.0),
        'state_ssd': normal((DEC_BATCH, DEPTH, N_DIR, SSD_HEADS, HEAD_DIM, SSD_STATE), 0.3),
        'state_rwkv': normal((DEC_BATCH, DEPTH, N_DIR, RWKV_HEADS, HEAD_DIM, HEAD_DIM), 0.3),
        'c': normal((DEC_BATCH, D_MODEL), 1.0),
        'c_ctx': normal((D_MODEL,), 1.0),
        'w_mod': normal((L, D_MODEL, 6 * D_MODEL), 0.5 * D_MODEL ** -0.5),
        'b_mod': normal((L, 6 * D_MODEL), 0.02),
        'w_in': normal((L, D_MODEL, IN_COLS), D_MODEL ** -0.5),
        'w_out': normal((L, D_MODEL, D_MODEL), DEEPNORM_BETA * D_MODEL ** -0.5),
        'attn_sink': normal((L, ATT_HEADS), 1.0),
        'ssd_conv_w': normal((L, SSD_CONV, SSD_CONV_CH), SSD_CONV ** -0.5),
        'ssd_conv_b': normal((L, SSD_CONV_CH), 0.02),
        'ssd_dt_bias': dt0 + jnp.log(-jnp.expm1(-dt0)),
        'ssd_a_log': jnp.log(uniform((L, N_DIR, SSD_HEADS), 1.0, 16.0)),
        'ssd_d': 1.0 + normal((L, SSD_HEADS), 0.1),
        'ssd_norm_w': 1.0 + normal((L, SSD_WIDTH), 0.02),
        'rwkv_mu': uniform((L, RWKV_COLS), 0.0, 1.0),
        'rwkv_w0': uniform((L, N_DIR, RWKV_WIDTH), -6.0, -1.0),
        'rwkv_w_up': normal((L, N_DIR, RWKV_W_RANK, RWKV_WIDTH), 0.1),
        'rwkv_a0': normal((L, N_DIR, RWKV_WIDTH), 0.1),
        'rwkv_a_up': normal((L, N_DIR, RWKV_A_RANK, RWKV_WIDTH), RWKV_A_RANK ** -0.5),
        'rwkv_g_up': normal((L, RWKV_G_RANK, RWKV_WIDTH), RWKV_G_RANK ** -0.5),
        'rwkv_k_k': 0.85 + normal((L, RWKV_WIDTH), 0.05),
        'rwkv_k_a': 1.0 + normal((L, RWKV_WIDTH), 0.05),
        'rwkv_r_k': normal((L, RWKV_HEADS, HEAD_DIM), 0.1),
        'rwkv_gn_w': 1.0 + normal((L, RWKV_WIDTH), 0.02),
        'rwkv_gn_b': normal((L, RWKV_WIDTH), 0.02),
        'ln1_w': 1.0 + normal((L, D_MODEL), 0.02),
        'ln1_b': normal((L, D_MODEL), 0.02),
        'ln2_w': 1.0 + normal((L, D_MODEL), 0.02),
        'ln2_b': normal((L, D_MODEL), 0.02),
        'ffn_w_in': normal((L, D_MODEL, 2 * FFN_HIDDEN), D_MODEL ** -0.5),
        'ffn_w_out': normal((L, FFN_HIDDEN, D_MODEL), DEEPNORM_BETA * FFN_HIDDEN ** -0.5),
    }


def reference(x_prompt, x_sample, cache_k, cache_v, state_ssd, state_rwkv, c, c_ctx,
              w_mod, b_mod, w_in, w_out, attn_sink, ssd_conv_w, ssd_conv_b, ssd_dt_bias,
              ssd_a_log, ssd_d, ssd_norm_w, rwkv_mu, rwkv_w0, rwkv_w_up, rwkv_a0, rwkv_a_up,
              rwkv_g_up, rwkv_k_k, rwkv_k_a, rwkv_r_k, rwkv_gn_w, rwkv_gn_b,
              ln1_w, ln1_b, ln2_w, ln2_b, ffn_w_in, ffn_w_out):
    xp, xs = x_prompt, x_sample
    k_list, v_list, ssd_list, rwkv_list = [], [], [], []
    for l in range(DEPTH):
        lp = {
            'w_in': w_in[l], 'w_out': w_out[l], 'attn_sink': attn_sink[l],
            'ssd_conv_w': ssd_conv_w[l], 'ssd_conv_b': ssd_conv_b[l], 'ssd_dt_bias': ssd_dt_bias[l],
            'ssd_a_log': ssd_a_log[l], 'ssd_d': ssd_d[l], 'ssd_norm_w': ssd_norm_w[l],
            'rwkv_mu': rwkv_mu[l], 'rwkv_w0': rwkv_w0[l], 'rwkv_w_up': rwkv_w_up[l],
            'rwkv_a0': rwkv_a0[l], 'rwkv_a_up': rwkv_a_up[l], 'rwkv_g_up': rwkv_g_up[l],
            'rwkv_k_k': rwkv_k_k[l], 'rwkv_k_a': rwkv_k_a[l], 'rwkv_r_k': rwkv_r_k[l],
            'rwkv_gn_w': rwkv_gn_w[l], 'rwkv_gn_b': rwkv_gn_b[l],
            'ln1_w': ln1_w[l], 'ln1_b': ln1_b[l], 'ln2_w': ln2_w[l], 'ln2_b': ln2_b[l],
            'ffn_w_in': ffn_w_in[l], 'ffn_w_out': ffn_w_out[l],
        }
        mod_ctx = adaln_modulation(c_ctx[None, :], w_mod[l], b_mod[l])
        xp, (k_c, v_c, s_ssd, s_rwkv) = trunk_layer(xp, mod_ctx, lp, None)
        k_list.append(k_c)
        v_list.append(v_c)
        ssd_list.append(s_ssd)
        rwkv_list.append(s_rwkv)
        mod_lat = adaln_modulation(c, w_mod[l], b_mod[l])
        xs, _ = trunk_layer(xs, mod_lat, lp, (cache_k[:, l], cache_v[:, l], state_ssd[:, l], state_rwkv[:, l]))
    new_cache_k = jnp.stack(k_list, axis=1)
    new_cache_v = jnp.stack(v_list, axis=1)
    new_state_ssd = jnp.stack(ssd_list, axis=1)
    new_state_rwkv = jnp.stack(rwkv_list, axis=1)
    return (xp, xs, new_cache_k, new_cache_v, new_state_ssd, new_state_rwkv)
```

```cpp
#include <hip/hip_runtime.h>
#include <hip/hip_cooperative_groups.h>
#include <stdint.h>
#include <stdio.h>
namespace cg = cooperative_groups;

#ifndef MEGA
#define MEGA 1
#endif

#define DI __device__ __forceinline__
typedef __attribute__((ext_vector_type(8))) short bf16x8;
typedef __attribute__((ext_vector_type(4))) float f32x4;
typedef unsigned short bf16_t;

constexpr int NTOK = 20480, NCTX = 4096;
constexpr int PROJ_LD = 2704, LR_LD = 1280, OUTS_LD = 1280, HID_LD = 2816;
constexpr size_t OFF_K = 20971520, OFF_V = 22020096, OFF_SSD = 23068672, OFF_RWKV = 24641536;
constexpr int TS = 16;
constexpr int RW0 = 1680;
constexpr int SMEM_BYTES = 73728;

DI float bf2f(bf16_t h) { return __uint_as_float(((unsigned)h) << 16); }
DI bf16_t f2bf(float f) { unsigned u = __float_as_uint(f); u += 0x7fffu + ((u >> 16) & 1u); return (bf16_t)(u >> 16); }
DI float sigmoidf_(float x) { return 1.f / (1.f + __expf(-x)); }
DI float siluf_(float x) { return x / (1.f + __expf(-x)); }

template <int CTRL> DI float dpp_f(float x) {
  return __builtin_bit_cast(float, __builtin_amdgcn_update_dpp(0, __builtin_bit_cast(int, x), CTRL, 0xf, 0xf, false));
}
DI float row16_sum(float x) { x += dpp_f<0x128>(x); x += dpp_f<0x124>(x); x += dpp_f<0x122>(x); x += dpp_f<0x121>(x); return x; }
DI float row16_max(float x) { x = fmaxf(x, dpp_f<0x128>(x)); x = fmaxf(x, dpp_f<0x124>(x)); x = fmaxf(x, dpp_f<0x122>(x)); x = fmaxf(x, dpp_f<0x121>(x)); return x; }
DI float wave_sum(float x) { x = row16_sum(x); x += __shfl_xor(x, 16); x += __shfl_xor(x, 32); return x; }

DI int my_tid() { int t = threadIdx.x; asm volatile("" : "+v"(t)); return t; }

struct P {
  const float *x_prompt, *x_sample, *cache_k, *cache_v, *state_ssd, *state_rwkv, *c, *c_ctx;
  const float *w_mod, *b_mod, *w_in, *w_out, *attn_sink, *ssd_conv_w, *ssd_conv_b, *ssd_dt_bias, *ssd_a_log, *ssd_d, *ssd_norm_w;
  const float *rwkv_mu, *rwkv_w0, *rwkv_w_up, *rwkv_a0, *rwkv_a_up, *rwkv_g_up, *rwkv_k_k, *rwkv_k_a, *rwkv_r_k, *rwkv_gn_w, *rwkv_gn_b;
  const float *ln1_w, *ln1_b, *ln2_w, *ln2_b, *ffn_w_in, *ffn_w_out;
  float* out;
  float* mod;
  float* rope;
  unsigned* counters;
  unsigned* bar;
  float* smid;
  bf16_t *Wlr;
  bf16_t *Win;
  bf16_t *Wout;
  bf16_t *Wffi;
  bf16_t *Wffo;
  bf16_t *proj;
  bf16_t *hidden;
  bf16_t *lr;
  bf16_t *mixA;
  bf16_t *outs;
  bf16_t *Alr;
  bf16_t *hA;
};

DI void tok_info(int tok, int& base, int& t, int& T, int& cj) {
  if (tok < NCTX) { base = tok & ~255; t = tok & 255; T = 256; cj = 0; }
  else { int u = tok - NCTX; base = NCTX + (u & ~4095); t = u & 4095; T = 4096; cj = 1 + (u >> 12); }
}

DI void p0_mod(const P& p, int item, float* smem) {
  int kh = item & 1; item >>= 1;
  int l = item / 96, nbk = item % 96;
  int tid = my_tid(), lane = tid & 63, wv = tid >> 6;
  float* s_c = smem;
  for (int i = tid; i < 5 * 512; i += 256) {
    int j = i >> 9, k = kh * 512 + (i & 511);
    float v = (j == 0) ? p.c_ctx[k] : p.c[(j - 1) * 1024 + k];
    s_c[i] = siluf_(v);
  }
  __syncthreads();
  const float* W = p.w_mod + (size_t)l * 1024 * 6144 + (size_t)(kh * 512) * 6144 + nbk * 64 + lane;
  float a0 = 0, a1 = 0, a2 = 0, a3 = 0, a4 = 0;
  int k0 = wv * 128;
#pragma unroll 16
  for (int k = k0; k < k0 + 128; ++k) {
    float w = W[(size_t)k * 6144];
    a0 += s_c[k] * w; a1 += s_c[512 + k] * w; a2 += s_c[1024 + k] * w; a3 += s_c[1536 + k] * w; a4 += s_c[2048 + k] * w;
  }
  float* s_red = smem + 5 * 512;
  s_red[(wv * 5 + 0) * 64 + lane] = a0; s_red[(wv * 5 + 1) * 64 + lane] = a1; s_red[(wv * 5 + 2) * 64 + lane] = a2;
  s_red[(wv * 5 + 3) * 64 + lane] = a3; s_red[(wv * 5 + 4) * 64 + lane] = a4;
  __syncthreads();
  if (tid < 64) {
    float bm = kh ? 0.f : p.b_mod[l * 6144 + nbk * 64 + tid];
    for (int j = 0; j < 5; ++j) {
      float s = bm;
      for (int w = 0; w < 4; ++w) s += s_red[(w * 5 + j) * 64 + tid];
      atomicAdd(&p.mod[(size_t)(l * 5 + j) * 6144 + nbk * 64 + tid], s);
    }
  }
  __syncthreads();
}

DI void conv_tile(const float* __restrict__ src, int K, int N, bf16_t* __restrict__ dst, int kt, int nt, int mapmode, float* smem) {
  int tid = my_tid(), lane = tid & 63, wv = tid >> 6;
  int np = nt * 64 + lane;
  int ncol;
  if (mapmode == 0) ncol = (np < N) ? np : -1;
  else if (mapmode == 2) ncol = (np < 1676) ? np : ((np < 1680) ? -1 : ((np < 2704) ? np - 4 : -1));
  else { int blk = np >> 5, w = np & 31; ncol = (w < 16) ? (blk * 16 + w) : (2816 + blk * 16 + (w - 16)); }
  for (int i = wv; i < 64; i += 4) {
    float v = (ncol >= 0) ? src[(size_t)(kt * 64 + i) * N + ncol] : 0.f;
    smem[i * 65 + lane] = v;
  }
  __syncthreads();
  for (int i = wv; i < 64; i += 4) dst[(size_t)(nt * 64 + i) * K + kt * 64 + lane] = f2bf(smem[lane * 65 + i]);
  __syncthreads();
}

DI void conv_win_item(const P& p, int l, int it, float* smem) {
  conv_tile(p.w_in + (size_t)l * 1024 * 2700, 1024, 2700, p.Win + (size_t)l * 2816 * 1024, it % 16, it / 16, 2, smem);
}
DI void conv_rest_item(const P& p, int l, int it, float* smem) {
  if (it < 256) conv_tile(p.w_out + (size_t)l * 1024 * 1024, 1024, 1024, p.Wout, it % 16, it / 16, 0, smem);
  else if (it < 256 + 1408) { it -= 256; conv_tile(p.ffn_w_in + (size_t)l * 1024 * 5632, 1024, 5632, p.Wffi, it % 16, it / 16, 1, smem); }
  else { it -= 256 + 1408; conv_tile(p.ffn_w_out + (size_t)l * 2816 * 1024, 2816, 1024, p.Wffo, it % 44, it / 44, 0, smem); }
}
DI void wlr_item(const P& p, int it) {
  for (int e = it * 4096 + my_tid(); e < it * 4096 + 4096; e += 256) {
    int l = e / 327680, rem = e % 327680, n = rem >> 8, k = rem & 255;
    float v = 0.f;
    int c = n & 255;
    if (n < 512) { int d = n >> 8; if (k < 64) v = p.rwkv_w_up[((size_t)(l * 2 + d) * 64 + k) * 256 + c]; }
    else if (n < 1024) { int d = (n - 512) >> 8; if (k >= 64 && k < 128) v = p.rwkv_a_up[((size_t)(l * 2 + d) * 64 + (k - 64)) * 256 + c]; }
    else { if (k >= 128) v = p.rwkv_g_up[((size_t)l * 128 + (k - 128)) * 256 + c]; }
    p.Wlr[e] = f2bf(v);
  }
}
DI void phase0(const P& p, int bid, int nb, float* smem) {
  const int n_mod = 384, n_win = 1408, n_rest = 0, n_wlr = 160;
  const int total = n_mod + n_win + n_rest + n_wlr + 1;
  for (int it = bid; it < total; it += nb) {
    int i = it;
    if (i < n_mod) { p0_mod(p, i, smem); continue; } i -= n_mod;
    if (i < n_win) { conv_win_item(p, i / 704, i % 704, smem); continue; } i -= n_win;
    if (i < n_rest) { conv_rest_item(p, 0, i, smem); continue; } i -= n_rest;
    if (i < n_wlr) { wlr_item(p, i); continue; }
    for (int e = my_tid(); e < 1024; e += 256) {
      int pos = e >> 4, f = e & 15;
      float inv = 1.0f / powf(10000.0f, (float)(2 * f) / 32.0f);
      float ang = (float)pos * inv;
      p.rope[e * 2] = cosf(ang); p.rope[e * 2 + 1] = sinf(ang);
    }
  }
}

DI void lnmod_phase(const P& p, int ln_kind, int ln_l, int mod_l, int mod_off, int bid, int nb) {
  int wv = my_tid() >> 6, lane = my_tid() & 63;
  float4 lw[4], lb[4];
  if (ln_kind != 0) {
    const float* lwp = (ln_kind == 1 ? p.ln1_w : p.ln2_w) + ln_l * 1024;
    const float* lbp = (ln_kind == 1 ? p.ln1_b : p.ln2_b) + ln_l * 1024;
#pragma unroll
    for (int i = 0; i < 4; ++i) { lw[i] = ((const float4*)lwp)[lane + 64 * i]; lb[i] = ((const float4*)lbp)[lane + 64 * i]; }
  }
  auto srcp = [&](int tok) -> const float4* {
    return (const float4*)((ln_kind == 0) ? (tok < NCTX ? p.x_prompt + (size_t)tok * 1024 : p.x_sample + (size_t)(tok - NCTX) * 1024)
                                          : p.out + (size_t)tok * 1024);
  };
  const int stride = nb * 4;
  int tok = bid * 4 + wv;
  float4 vn[4];
  if (tok < NTOK) {
    const float4* sp = srcp(tok);
#pragma unroll
    for (int i = 0; i < 4; ++i) vn[i] = sp[lane + 64 * i];
  }
  for (; tok < NTOK; tok += stride) {
    float4 v[4];
#pragma unroll
    for (int i = 0; i < 4; ++i) v[i] = vn[i];
    if (tok + stride < NTOK) {
      const float4* sp = srcp(tok + stride);
#pragma unroll
      for (int i = 0; i < 4; ++i) vn[i] = sp[lane + 64 * i];
    }
    int base, t, T, cj; tok_info(tok, base, t, T, cj);
    float4 sh[4], sc[4];
    if (mod_off >= 0) {
      const float* md = p.mod + (size_t)(mod_l * 5 + cj) * 6144 + mod_off;
#pragma unroll
      for (int i = 0; i < 4; ++i) { sh[i] = ((const float4*)md)[lane + 64 * i]; sc[i] = ((const float4*)(md + 1024))[lane + 64 * i]; }
    }
    if (ln_kind != 0) {
      float s = 0;
#pragma unroll
      for (int i = 0; i < 4; ++i) s += v[i].x + v[i].y + v[i].z + v[i].w;
      float mu = wave_sum(s) * (1.f / 1024.f);
      float ss = 0;
#pragma unroll
      for (int i = 0; i < 4; ++i) { float a = v[i].x - mu, b = v[i].y - mu, c = v[i].z - mu, d = v[i].w - mu; ss += a * a + b * b + c * c + d * d; }
      float rs = rsqrtf(wave_sum(ss) * (1.f / 1024.f) + 1e-5f);
#pragma unroll
      for (int i = 0; i < 4; ++i) {
        v[i].x = (v[i].x - mu) * rs * lw[i].x + lb[i].x; v[i].y = (v[i].y - mu) * rs * lw[i].y + lb[i].y;
        v[i].z = (v[i].z - mu) * rs * lw[i].z + lb[i].z; v[i].w = (v[i].w - mu) * rs * lw[i].w + lb[i].w;
      }
    }
    float4* dst = (float4*)(p.out + (size_t)tok * 1024);
#pragma unroll
    for (int i = 0; i < 4; ++i) dst[lane + 64 * i] = v[i];
    if (mod_off >= 0) {
#pragma unroll
      for (int i = 0; i < 4; ++i) {
        ushort4 o;
        o.x = f2bf(v[i].x * (1.f + sc[i].x) + sh[i].x); o.y = f2bf(v[i].y * (1.f + sc[i].y) + sh[i].y);
        o.z = f2bf(v[i].z * (1.f + sc[i].z) + sh[i].z); o.w = f2bf(v[i].w * (1.f + sc[i].w) + sh[i].w);
        ((ushort4*)(p.hA + (size_t)tok * 1024))[lane + 64 * i] = o;
      }
    }
  }
}

template <class Epi>
DI void gemm_phase(const bf16_t* __restrict__ A0, int lda0, const bf16_t* __restrict__ A1, int lda1, int ksplit,
                   const bf16_t* __restrict__ B, int Mt, int Nt, int K, Epi epi, int bid, int nb, char* smem) {
  bf16_t* As = (bf16_t*)smem;
  bf16_t* Bs = As + 2 * 128 * 32;
  const int tid = my_tid(), lane = tid & 63, wv = tid >> 6, wm = wv >> 1, wn = wv & 1, r = lane & 15, q = lane >> 4;
  const int lrow = tid >> 2, lk = (tid & 3) * 8;
  const int lsw = (((tid & 3) ^ ((lrow >> 2) & 3)) * 8);
  const int fsw = ((q ^ ((r >> 2) & 3)) * 8);
  const int nk = K / 32;
  const int xcd = bid & 7, jb = bid >> 3, nbx = nb >> 3, mpx = Mt >> 3;
  const int ntx = mpx * Nt;
  for (int idx = jb; idx < ntx; idx += nbx) {
    const int g = idx / (4 * Nt), rem = idx - g * 4 * Nt;
    const int nt = rem >> 2, mt = xcd * mpx + g * 4 + (rem & 3);
    f32x4 acc[4][4];
#pragma unroll
    for (int i = 0; i < 4; ++i)
#pragma unroll
      for (int j = 0; j < 4; ++j) acc[i][j] = (f32x4){0.f, 0.f, 0.f, 0.f};
    uint4 a00, a01, b00, b01, a10, a11, b10, b11;
#define GLOAD(kt_, x0, x1, y0, y1) { int k0 = (kt_) * 32; const bf16_t* Ap = A0; int lda = lda0; int kk = k0; \
      if (k0 >= ksplit) { Ap = A1; lda = lda1; kk = k0 - ksplit; } \
      x0 = *(const uint4*)(Ap + (size_t)(mt * 128 + lrow) * lda + kk + lk); \
      x1 = *(const uint4*)(Ap + (size_t)(mt * 128 + lrow + 64) * lda + kk + lk); \
      y0 = *(const uint4*)(B + (size_t)(nt * 128 + lrow) * K + k0 + lk); \
      y1 = *(const uint4*)(B + (size_t)(nt * 128 + lrow + 64) * K + k0 + lk); }
#define LSTORE(buf_, x0, x1, y0, y1) { bf16_t* an = As + (buf_) * 128 * 32; bf16_t* bn = Bs + (buf_) * 128 * 32; \
      *(uint4*)(an + lrow * 32 + lsw) = x0; *(uint4*)(an + (lrow + 64) * 32 + lsw) = x1; \
      *(uint4*)(bn + lrow * 32 + lsw) = y0; *(uint4*)(bn + (lrow + 64) * 32 + lsw) = y1; }
    auto compute = [&](int buf) {
      const bf16_t* as = As + buf * 128 * 32;
      const bf16_t* bs = Bs + buf * 128 * 32;
      bf16x8 af[4], bfr[4];
#pragma unroll
      for (int i = 0; i < 4; ++i) af[i] = *(const bf16x8*)(as + (wm * 64 + i * 16 + r) * 32 + fsw);
#pragma unroll
      for (int j = 0; j < 4; ++j) bfr[j] = *(const bf16x8*)(bs + (wn * 64 + j * 16 + r) * 32 + fsw);
#pragma unroll
      for (int i = 0; i < 4; ++i)
#pragma unroll
        for (int j = 0; j < 4; ++j) acc[i][j] = __builtin_amdgcn_mfma_f32_16x16x32_bf16(af[i], bfr[j], acc[i][j], 0, 0, 0);
    };
    GLOAD(0, a00, a01, b00, b01);
    GLOAD(1, a10, a11, b10, b11);
    LSTORE(0, a00, a01, b00, b01);
    __syncthreads();
    for (int kt = 0; kt < nk; kt += 2) {
      if (kt + 2 < nk) GLOAD(kt + 2, a00, a01, b00, b01);
      compute(0);
      LSTORE(1, a10, a11, b10, b11);
      __syncthreads();
      if (kt + 3 < nk) GLOAD(kt + 3, a10, a11, b10, b11);
      compute(1);
      if (kt + 2 < nk) LSTORE(0, a00, a01, b00, b01);
      __syncthreads();
    }
    epi(acc, mt * 128 + wm * 64, nt * 128 + wn * 64, r, q);
  }
}

#define RAW_BARRIER() do { asm volatile("s_waitcnt lgkmcnt(0)" ::: "memory"); __builtin_amdgcn_s_barrier(); asm volatile("" ::: "memory"); } while (0)
template <class Epi>
DI void gemm_phase_dma(const bf16_t* __restrict__ A0, int lda0, const bf16_t* __restrict__ A1, int lda1, int ksplit,
                       const bf16_t* __restrict__ B, int Mt, int Nt, int K, Epi epi, int bid, int nb, char* smem) {
  bf16_t* Ls = (bf16_t*)smem;
  const int tid = my_tid(), lane = tid & 63, wv = tid >> 6, wm = wv >> 1, wn = wv & 1, r = lane & 15, q = lane >> 4;
  const int fsw = ((q ^ ((r >> 2) & 3)) * 8);
  const int lr_ = lane >> 2, ls_ = lane & 3;
  const int csrc = (ls_ ^ ((lr_ >> 2) & 3)) * 8;
  const int nk = K / 32;
  const int xcd = bid & 7, jb = bid >> 3, nbx = nb >> 3, mpx = Mt >> 3;
  const int ntx = mpx * Nt;
  const int wrow = __builtin_amdgcn_readfirstlane(wv) * 32;
  int mt = 0, nt = 0; size_t arow = 0; const bf16_t* bsrc = B;
  auto set_tile = [&](int idx_) {
    const int g = idx_ / (4 * Nt), rem = idx_ - g * 4 * Nt;
    nt = rem >> 2; mt = xcd * mpx + g * 4 + (rem & 3);
    arow = (size_t)(mt * 128 + wrow + lr_);
    bsrc = B + (size_t)(nt * 128 + wrow + lr_) * K + csrc;
  };
  int idx = jb;
  if (idx < ntx) set_tile(idx);
  bool primed = false;
  while (idx < ntx) {
    const int cmt = mt, cnt = nt;
    f32x4 acc[4][4];
#pragma unroll
    for (int i = 0; i < 4; ++i)
#pragma unroll
      for (int j = 0; j < 4; ++j) acc[i][j] = (f32x4){0.f, 0.f, 0.f, 0.f};
    auto glds = [&](int kt, int st) {
      const int k0 = kt * 32;
      const bf16_t* Ap = A0; int lda = lda0; int kk = k0;
      if (k0 >= ksplit) { Ap = A1; lda = lda1; kk = k0 - ksplit; }
      const bf16_t* asrc = Ap + arow * lda + kk + csrc;
      bf16_t* la = Ls + st * 8192 + wrow * 32;
      __builtin_amdgcn_global_load_lds((const unsigned*)asrc, (__attribute__((address_space(3))) unsigned*)la, 16, 0, 0);
      __builtin_amdgcn_global_load_lds((const unsigned*)(asrc + (size_t)16 * lda), (__attribute__((address_space(3))) unsigned*)(la + 16 * 32), 16, 0, 0);
      bf16_t* lb = la + 4096;
      __builtin_amdgcn_global_load_lds((const unsigned*)(bsrc + k0), (__attribute__((address_space(3))) unsigned*)lb, 16, 0, 0);
      __builtin_amdgcn_global_load_lds((const unsigned*)(bsrc + (size_t)16 * K + k0), (__attribute__((address_space(3))) unsigned*)(lb + 16 * 32), 16, 0, 0);
    };
    const unsigned aaddr0 = (unsigned)(size_t)smem + (unsigned)(((wm * 64 + r) * 32 + fsw) * 2);
    const unsigned baddr0 = (unsigned)(size_t)smem + 8192u + (unsigned)(((wn * 64 + r) * 32 + fsw) * 2);
    auto compute = [&](int st) {
      bf16x8 af0, af1, af2, af3, bf0, bf1, bf2, bf3;
      const unsigned aa = aaddr0 + (unsigned)st * 16384u, ba = baddr0 + (unsigned)st * 16384u;
      asm volatile("ds_read_b128 %0, %8\n\tds_read_b128 %1, %8 offset:1024\n\tds_read_b128 %2, %8 offset:2048\n\tds_read_b128 %3, %8 offset:3072\n\t"
                   "ds_read_b128 %4, %9\n\tds_read_b128 %5, %9 offset:1024\n\tds_read_b128 %6, %9 offset:2048\n\tds_read_b128 %7, %9 offset:3072\n\t"
                   "s_waitcnt lgkmcnt(0)"
                   : "=&v"(af0), "=&v"(af1), "=&v"(af2), "=&v"(af3), "=&v"(bf0), "=&v"(bf1), "=&v"(bf2), "=&v"(bf3)
                   : "v"(aa), "v"(ba) : "memory");
#define MF(i_, a_) acc[i_][0] = __builtin_amdgcn_mfma_f32_16x16x32_bf16(a_, bf0, acc[i_][0], 0, 0, 0); \
                   acc[i_][1] = __builtin_amdgcn_mfma_f32_16x16x32_bf16(a_, bf1, acc[i_][1], 0, 0, 0); \
                   acc[i_][2] = __builtin_amdgcn_mfma_f32_16x16x32_bf16(a_, bf2, acc[i_][2], 0, 0, 0); \
                   acc[i_][3] = __builtin_amdgcn_mfma_f32_16x16x32_bf16(a_, bf3, acc[i_][3], 0, 0, 0);
      MF(0, af0) MF(1, af1) MF(2, af2) MF(3, af3)
#undef MF
    };
    if (!primed) { asm volatile("s_waitcnt vmcnt(0)" ::: "memory"); glds(0, 0); glds(1, 1); primed = true; }
    else asm volatile("s_waitcnt vmcnt(0)" ::: "memory");
    int st = 0, st2 = 2;
    for (int kt = 0; kt < nk; ++kt) {
      if (kt + 1 < nk) asm volatile("s_waitcnt vmcnt(4)" ::: "memory");
      else asm volatile("s_waitcnt vmcnt(0)" ::: "memory");
      RAW_BARRIER();
      if (kt + 2 < nk) glds(kt + 2, st2);
      compute(st);
      st = (st == 2) ? 0 : st + 1;
      st2 = (st2 == 2) ? 0 : st2 + 1;
    }
    RAW_BARRIER();
    const int nidx = idx + nbx;
    if (nidx < ntx) { set_tile(nidx); glds(0, 0); glds(1, 1); }
    epi(acc, cmt * 128 + wm * 64, cnt * 128 + wn * 64, r, q);
    idx = nidx;
  }
}

template <class Epi>
DI void gemm_phase_dma256(const bf16_t* __restrict__ A, int lda, const bf16_t* __restrict__ B, int Mt, int Nt, int K, Epi epi, int bid, int nb, char* smem) {
  bf16_t* Ls = (bf16_t*)smem;
  const int tid = my_tid(), lane = tid & 63, wv = tid >> 6, wm = wv >> 1, wn = wv & 1, r = lane & 15, q = lane >> 4;
  const int fsw = ((q ^ ((r >> 2) & 3)) * 8);
  const int lr_ = lane >> 2, ls_ = lane & 3;
  const int csrc = (ls_ ^ ((lr_ >> 2) & 3)) * 8;
  const int nk = K / 32;
  const int xcd = bid & 7, jb = bid >> 3, nbx = nb >> 3, mpx = Mt >> 3;
  const int ntx = mpx * Nt;
  const int wvu = __builtin_amdgcn_readfirstlane(wv);
  const unsigned aaddr0 = (unsigned)(size_t)smem + (unsigned)(((wm * 128 + r) * 32 + fsw) * 2);
  const unsigned baddr0 = (unsigned)(size_t)smem + 16384u + (unsigned)(((wn * 64 + r) * 32 + fsw) * 2);
  int mt = 0, nt = 0; const bf16_t* asrc = A; const bf16_t* bsrc = B;
  auto set_tile = [&](int idx_) {
    const int g = idx_ / (2 * Nt), rem = idx_ - g * 2 * Nt;
    nt = rem >> 1; mt = xcd * mpx + g * 2 + (rem & 1);
    asrc = A + (size_t)(mt * 256 + wvu * 64 + lr_) * lda + csrc;
    bsrc = B + (size_t)(nt * 128 + wvu * 32 + lr_) * K + csrc;
  };
  int idx = jb;
  if (idx < ntx) set_tile(idx);
  bool primed = false;
  while (idx < ntx) {
    const int cmt = mt, cnt = nt;
    f32x4 accA[4][4], accB[4][4];
#pragma unroll
    for (int i = 0; i < 4; ++i)
#pragma unroll
      for (int j = 0; j < 4; ++j) { accA[i][j] = (f32x4){0.f, 0.f, 0.f, 0.f}; accB[i][j] = (f32x4){0.f, 0.f, 0.f, 0.f}; }
    auto glds = [&](int kt, int st) {
      const int k0 = kt * 32;
      bf16_t* la = Ls + st * 12288 + wvu * 64 * 32;
#pragma unroll
      for (int u = 0; u < 4; ++u)
        __builtin_amdgcn_global_load_lds((const unsigned*)(asrc + (size_t)(u * 16) * lda + k0), (__attribute__((address_space(3))) unsigned*)(la + u * 16 * 32), 16, 0, 0);
      bf16_t* lb = Ls + st * 12288 + 8192 + wvu * 32 * 32;
#pragma unroll
      for (int u = 0; u < 2; ++u)
        __builtin_amdgcn_global_load_lds((const unsigned*)(bsrc + (size_t)(u * 16) * K + k0), (__attribute__((address_space(3))) unsigned*)(lb + u * 16 * 32), 16, 0, 0);
    };
    auto compute = [&](int st) {
      bf16x8 af0, af1, af2, af3, bf0, bf1, bf2, bf3;
      const unsigned aa = aaddr0 + (unsigned)st * 24576u, ba = baddr0 + (unsigned)st * 24576u;
      asm volatile("ds_read_b128 %0, %8\n\tds_read_b128 %1, %8 offset:1024\n\tds_read_b128 %2, %8 offset:2048\n\tds_read_b128 %3, %8 offset:3072\n\t"
                   "ds_read_b128 %4, %9\n\tds_read_b128 %5, %9 offset:1024\n\tds_read_b128 %6, %9 offset:2048\n\tds_read_b128 %7, %9 offset:3072\n\t"
                   "s_waitcnt lgkmcnt(0)"
                   : "=&v"(af0), "=&v"(af1), "=&v"(af2), "=&v"(af3), "=&v"(bf0), "=&v"(bf1), "=&v"(bf2), "=&v"(bf3)
                   : "v"(aa), "v"(ba) : "memory");
#define MF(acc_, i_, a_) acc_[i_][0] = __builtin_amdgcn_mfma_f32_16x16x32_bf16(a_, bf0, acc_[i_][0], 0, 0, 0); \
                         acc_[i_][1] = __builtin_amdgcn_mfma_f32_16x16x32_bf16(a_, bf1, acc_[i_][1], 0, 0, 0); \
                         acc_[i_][2] = __builtin_amdgcn_mfma_f32_16x16x32_bf16(a_, bf2, acc_[i_][2], 0, 0, 0); \
                         acc_[i_][3] = __builtin_amdgcn_mfma_f32_16x16x32_bf16(a_, bf3, acc_[i_][3], 0, 0, 0);
      MF(accA, 0, af0) MF(accA, 1, af1) MF(accA, 2, af2) MF(accA, 3, af3)
      bf16x8 ag0, ag1, ag2, ag3;
      asm volatile("ds_read_b128 %0, %4 offset:4096\n\tds_read_b128 %1, %4 offset:5120\n\tds_read_b128 %2, %4 offset:6144\n\tds_read_b128 %3, %4 offset:7168\n\t"
                   "s_waitcnt lgkmcnt(0)"
                   : "=&v"(ag0), "=&v"(ag1), "=&v"(ag2), "=&v"(ag3) : "v"(aa) : "memory");
      MF(accB, 0, ag0) MF(accB, 1, ag1) MF(accB, 2, ag2) MF(accB, 3, ag3)
#undef MF
    };
    if (!primed) { asm volatile("s_waitcnt vmcnt(0)" ::: "memory"); glds(0, 0); glds(1, 1); primed = true; }
    else asm volatile("s_waitcnt vmcnt(0)" ::: "memory");
    int st = 0, st2 = 2;
    for (int kt = 0; kt < nk; ++kt) {
      if (kt + 1 < nk) asm volatile("s_waitcnt vmcnt(6)" ::: "memory");
      else asm volatile("s_waitcnt vmcnt(0)" ::: "memory");
      RAW_BARRIER();
      if (kt + 2 < nk) glds(kt + 2, st2);
      compute(st);
      __builtin_amdgcn_sched_barrier(0);
      st = (st == 2) ? 0 : st + 1;
      st2 = (st2 == 2) ? 0 : st2 + 1;
    }
    RAW_BARRIER();
    const int nidx = idx + nbx;
    if (nidx < ntx) { set_tile(nidx); glds(0, 0); glds(1, 1); }
    epi(accA, cmt * 256 + wm * 128, cnt * 128 + wn * 64, r, q);
    asm volatile("" ::: "memory");
    __builtin_amdgcn_sched_barrier(0);
    epi(accB, cmt * 256 + wm * 128 + 64, cnt * 128 + wn * 64, r, q);
    idx = nidx;
  }
}

struct Epi1 {
  const P& p; int l;
  DI void operator()(f32x4 (&acc)[4][4], int m0, int n0, int r, int q) const {
#pragma unroll
    for (int i = 0; i < 4; ++i)
#pragma unroll
      for (int e = 0; e < 4; ++e) {
        int row = m0 + i * 16 + q * 4 + e;
        asm volatile("" : "+v"(row));
        bf16_t* pr = p.proj + (size_t)row * PROJ_LD + n0 + r;
#pragma unroll
        for (int j = 0; j < 4; ++j) if (n0 + j * 16 + r < PROJ_LD) pr[j * 16] = f2bf(acc[i][j][e]);
      }
    if (m0 < NCTX && n0 >= 384 && n0 < 640) {
      float* cb = p.out + ((n0 < 512) ? OFF_K : OFF_V) + ((n0 - 384) & 127) + r;
#pragma unroll
      for (int i = 0; i < 4; ++i)
#pragma unroll
        for (int e = 0; e < 4; ++e) {
          int row = m0 + i * 16 + q * 4 + e;
          asm volatile("" : "+v"(row));
          float* cr = cb + ((size_t)((row >> 8) * 2 + l) * 256 + (row & 255)) * 128;
#pragma unroll
          for (int j = 0; j < 4; ++j) cr[j * 16] = acc[i][j][e];
        }
    }
  }
};
struct EpiLR {
  const P& p; int l;
  DI void operator()(f32x4 (&acc)[4][4], int m0, int n0, int r, int q) const {
#pragma unroll
    for (int i = 0; i < 4; ++i)
#pragma unroll
      for (int j = 0; j < 4; ++j) {
        int col = n0 + j * 16 + r;
        float bias = 0.f; bool sg = false;
        if (col < 512) { bias = p.rwkv_w0[l * 512 + col]; sg = true; }
        else if (col < 1024) { bias = p.rwkv_a0[l * 512 + (col - 512)]; sg = true; }
#pragma unroll
        for (int e = 0; e < 4; ++e) {
          int row = m0 + i * 16 + q * 4 + e;
          float v = acc[i][j][e] + bias;
          if (sg) v = sigmoidf_(v);
          p.lr[(size_t)row * LR_LD + col] = f2bf(v);
        }
      }
  }
};
struct EpiRes {
  const P& p; int l; int gate_off;
  DI void operator()(f32x4 (&acc)[4][4], int m0, int n0, int r, int q) const {
    int base, t, T, cj; tok_info(m0, base, t, T, cj);
    const float* g = p.mod + (size_t)(l * 5 + cj) * 6144 + gate_off;
#pragma unroll
    for (int i = 0; i < 4; ++i)
#pragma unroll
      for (int j = 0; j < 4; ++j) {
        int col = n0 + j * 16 + r;
        float gv = g[col];
#pragma unroll
        for (int e = 0; e < 4; ++e) {
          int row = m0 + i * 16 + q * 4 + e;
          float* xp = p.out + (size_t)row * 1024 + col;
          *xp = 1.41421356237f * (*xp) + gv * acc[i][j][e];
        }
      }
  }
};
struct EpiFfn {
  const P& p;
  DI void operator()(f32x4 (&acc)[4][4], int m0, int n0, int r, int q) const {
#pragma unroll
    for (int i = 0; i < 4; ++i)
#pragma unroll
      for (int jp = 0; jp < 4; jp += 2) {
        int hc = ((n0 + jp * 16) >> 1) + r;
#pragma unroll
        for (int e = 0; e < 4; ++e) {
          int row = m0 + i * 16 + q * 4 + e;
          asm volatile("" : "+v"(row));
          float g = acc[i][jp][e], u = acc[i][jp + 1][e];
          p.hidden[(size_t)row * HID_LD + hc] = f2bf(siluf_(g) * u);
        }
      }
  }
};

DI float rw_mixed(const P& p, int l, int tok, int t, int T, int col) {
  const bf16_t* pr = p.proj + (size_t)tok * PROJ_LD + RW0 + col;
  float pc = bf2f(pr[0]);
  float pm = bf2f(pr[(t > 0) ? -PROJ_LD : 0]);
  float pn = bf2f(pr[(t < T - 1) ? PROJ_LD : 0]);
  pm = (t > 0) ? pm : 0.f; pn = (t < T - 1) ? pn : 0.f;
  float mu = p.rwkv_mu[l * 1024 + col];
  return pc + mu * (0.5f * (pm + pn) - pc);
}
DI float ssd_conv(const P& p, int l, int base, int t, int T, int ch) {
  float acc = p.ssd_conv_b[l * 640 + ch];
  float xv[5], wv_[5];
#pragma unroll
  for (int j = 0; j < 5; ++j) {
    int tt = t + j - 2;
    int tc = tt < 0 ? 0 : (tt > T - 1 ? T - 1 : tt);
    xv[j] = bf2f(p.proj[(size_t)(base + tc) * PROJ_LD + 1024 + ch]);
    wv_[j] = p.ssd_conv_w[(l * 5 + j) * 640 + ch];
  }
#pragma unroll
  for (int j = 0; j < 5; ++j) { int tt = t + j - 2; acc += (tt >= 0 && tt < T) ? wv_[j] * xv[j] : 0.f; }
  return siluf_(acc);
}

DI void prepA_phase(const P& p, int l, int bid, int nb) {
  const int j = my_tid();
  const float mu = p.rwkv_mu[l * 1024 + 768 + j];
  for (int tok0 = bid * 8; tok0 < NTOK; tok0 += nb * 8) {
    int base, t0, T, cj; tok_info(tok0, base, t0, T, cj);
    float v[10];
#pragma unroll
    for (int i = 0; i < 10; ++i) {
      int t = t0 - 1 + i;
      v[i] = (t >= 0 && t < T) ? bf2f(p.proj[(size_t)(base + t) * PROJ_LD + RW0 + 768 + j]) : 0.f;
    }
#pragma unroll
    for (int i = 0; i < 8; ++i) {
      float m = v[i + 1] + mu * (0.5f * (v[i] + v[i + 2]) - v[i + 1]);
      float o = (j < 64) ? tanhf(m) : ((j < 128) ? m : sigmoidf_(m));
      p.Alr[(size_t)(tok0 + i) * 256 + j] = f2bf(o);
    }
  }
}

DI void unpack4(uint2 u, float (&f)[4]) {
  f[0] = __uint_as_float(u.x << 16); f[1] = __uint_as_float(u.x & 0xffff0000u);
  f[2] = __uint_as_float(u.y << 16); f[3] = __uint_as_float(u.y & 0xffff0000u);
}
DI void rwkv_item(const P& p, int l, int ci, int rg, int unit, char* smemc) {
  const int tid = my_tid(), lane = tid & 63, wv = tid >> 6;
  int seq, h = (ci & 7) >> 1, d = ci & 1, base, T;
  bool latent = ci < 32;
  if (latent) { int b = ci >> 3; seq = b; base = NCTX + b * 4096; T = 4096; }
  else { int s = (ci - 32) >> 3; seq = s; base = s * 256; T = 256; }
  float* s_kk = (float*)smemc; float* s_w = s_kk + TS * 64; float* s_b = s_w + TS * 64; float* s_kd = s_b + TS * 64; float* s_r = s_kd + TS * 64;
  float* s_v = s_r + TS * 64; float* s_o = s_v + TS * 16;
  bf16_t* raw = (bf16_t*)(s_o + 2 * TS * 16);
  bf16_t* rawlr = raw + (TS + 2) * 192;
  const int rl = lane >> 4, kq = lane & 15;
  const int row = rg * 16 + wv * 4 + rl;
  const int sbeg = (unit == 1 || unit == 2) ? (T >> 1) : 0;
  const int send = (unit == 0) ? (T >> 1) : T;
  float4 S;
  if (unit == 0) S = *(const float4*)(p.state_rwkv + ((((size_t)(seq * 2 + l) * 2 + d) * 4 + h) * 64 + row) * 64 + kq * 4);
  else if (unit == 2) S = make_float4((kq * 4 + 0 == row) ? 1.f : 0.f, (kq * 4 + 1 == row) ? 1.f : 0.f, (kq * 4 + 2 == row) ? 1.f : 0.f, (kq * 4 + 3 == row) ? 1.f : 0.f);
  else S = make_float4(0.f, 0.f, 0.f, 0.f);
  const float vmask = (unit == 2) ? 0.f : 1.f;
  bf16_t* const obase = (unit == 2) ? (p.proj + RW0 + 768 + h * 64 + rg * 16) : (p.outs + d * 256 + h * 64 + rg * 16);
  const int old_ = (unit == 2) ? PROJ_LD : OUTS_LD;
  float mu_r[4], mu_k[4], mu_v[4], k_k[4], k_a[4];
#pragma unroll
  for (int e = 0; e < 4; ++e) {
    int c = h * 64 + kq * 4 + e;
    mu_r[e] = p.rwkv_mu[l * 1024 + c]; mu_k[e] = p.rwkv_mu[l * 1024 + 256 + c]; mu_v[e] = p.rwkv_mu[l * 1024 + 512 + c];
    k_k[e] = p.rwkv_k_k[l * 256 + c]; k_a[e] = p.rwkv_k_a[l * 256 + c];
  }
  constexpr int NRK = (TS + 2) * 24, NRT = NRK + TS * 16, NSL = (NRT + 255) / 256;
  uint4 rgA[NSL], rgB[NSL];
  auto load_rawA = [&](int c0) {
#pragma unroll
    for (int n = 0; n < NSL; ++n) {
      int s = tid + 256 * n;
      const uint4* src = nullptr;
      if (s < NRK) {
        int rw_ = s / 24, rem = s - rw_ * 24;
        int sidx = c0 - 1 + rw_;
        if (sidx >= 0 && sidx < T) {
          int t = d ? (T - 1 - sidx) : sidx;
          src = (const uint4*)(p.proj + (size_t)(base + t) * PROJ_LD + RW0 + (rem >> 3) * 256 + h * 64 + (rem & 7) * 8);
        }
      } else if (s < NRT) {
        int s2 = s - NRK;
        int i = s2 >> 4, rem = s2 & 15;
        int sidx = c0 + i;
        int t = d ? (T - 1 - sidx) : sidx;
        src = (const uint4*)(p.lr + (size_t)(base + t) * LR_LD + (rem >> 3) * 512 + d * 256 + h * 64 + (rem & 7) * 8);
      }
      rgA[n] = src ? *src : make_uint4(0u, 0u, 0u, 0u);
    }
  };
  auto load_rawB = [&](int c0) {
#pragma unroll
    for (int n = 0; n < NSL; ++n) {
      int s = tid + 256 * n;
      const uint4* src = nullptr;
      if (s < NRK) {
        int rw_ = s / 24, rem = s - rw_ * 24;
        int sidx = c0 - 1 + rw_;
        if (sidx >= 0 && sidx < T) {
          int t = d ? (T - 1 - sidx) : sidx;
          src = (const uint4*)(p.proj + (size_t)(base + t) * PROJ_LD + RW0 + (rem >> 3) * 256 + h * 64 + (rem & 7) * 8);
        }
      } else if (s < NRT) {
        int s2 = s - NRK;
        int i = s2 >> 4, rem = s2 & 15;
        int sidx = c0 + i;
        int t = d ? (T - 1 - sidx) : sidx;
        src = (const uint4*)(p.lr + (size_t)(base + t) * LR_LD + (rem >> 3) * 512 + d * 256 + h * 64 + (rem & 7) * 8);
      }
      rgB[n] = src ? *src : make_uint4(0u, 0u, 0u, 0u);
    }
  };
  asm volatile("" :: "v"(mu_r[0]), "v"(mu_r[1]), "v"(mu_r[2]), "v"(mu_r[3]), "v"(mu_k[0]), "v"(mu_k[1]), "v"(mu_k[2]), "v"(mu_k[3]),
               "v"(mu_v[0]), "v"(mu_v[1]), "v"(mu_v[2]), "v"(mu_v[3]), "v"(k_k[0]), "v"(k_k[1]), "v"(k_k[2]), "v"(k_k[3]),
               "v"(k_a[0]), "v"(k_a[1]), "v"(k_a[2]), "v"(k_a[3]), "v"(S.x), "v"(S.y), "v"(S.z), "v"(S.w));
  load_rawA(sbeg);
  load_rawB(sbeg + TS);
  auto rest = [&](int c0) {
    if (c0 > sbeg) {
      const float* so = s_o + (((c0 / TS) - 1) & 1) * TS * 16;
      int i = tid >> 4, rr = tid & 15;
      int sidx = c0 - TS + i;
      int t = d ? (T - 1 - sidx) : sidx;
      obase[(size_t)(base + t) * old_ + rr] = f2bf(so[tid]);
    }
#pragma unroll
    for (int pp = 0; pp < TS / 16; ++pp) {
      int i = pp * 16 + wv * 4 + rl;
      const bf16_t* rc = raw + (i + 1) * 192 + kq * 4;
      float rC[4], rM[4], rN[4], kC[4], kM[4], kN[4], vC[4], vM[4], vN[4], sw[4], aa[4];
      unpack4(*(const uint2*)(rc), rC); unpack4(*(const uint2*)(rc - 192), rM); unpack4(*(const uint2*)(rc + 192), rN);
      unpack4(*(const uint2*)(rc + 64), kC); unpack4(*(const uint2*)(rc + 64 - 192), kM); unpack4(*(const uint2*)(rc + 64 + 192), kN);
      unpack4(*(const uint2*)(rc + 128), vC); unpack4(*(const uint2*)(rc + 128 - 192), vM); unpack4(*(const uint2*)(rc + 128 + 192), vN);
      unpack4(*(const uint2*)(rawlr + i * 128 + kq * 4), sw); unpack4(*(const uint2*)(rawlr + i * 128 + 64 + kq * 4), aa);
      float rr[4], kx[4], vv[4], kkr[4], ww[4];
      float ssq = 0.f;
#pragma unroll
      for (int e = 0; e < 4; ++e) {
        rr[e] = rC[e] + mu_r[e] * (0.5f * (rM[e] + rN[e]) - rC[e]);
        kx[e] = kC[e] + mu_k[e] * (0.5f * (kM[e] + kN[e]) - kC[e]);
        vv[e] = vC[e] + mu_v[e] * (0.5f * (vM[e] + vN[e]) - vC[e]);
        ww[e] = __expf(-0.6065306597126334f * sw[e]);
        kkr[e] = kx[e] * k_k[e];
        ssq += kkr[e] * kkr[e];
      }
      ssq = row16_sum(ssq);
      float inv = rsqrtf(ssq + 1e-12f);
      float4 kk4, b4, kd4;
      kk4.x = kkr[0] * inv; kk4.y = kkr[1] * inv; kk4.z = kkr[2] * inv; kk4.w = kkr[3] * inv;
      b4.x = kk4.x * aa[0]; b4.y = kk4.y * aa[1]; b4.z = kk4.z * aa[2]; b4.w = kk4.w * aa[3];
      kd4.x = kx[0] * (1.f + (aa[0] - 1.f) * k_a[0]); kd4.y = kx[1] * (1.f + (aa[1] - 1.f) * k_a[1]);
      kd4.z = kx[2] * (1.f + (aa[2] - 1.f) * k_a[2]); kd4.w = kx[3] * (1.f + (aa[3] - 1.f) * k_a[3]);
      *(float4*)(s_kk + i * 64 + kq * 4) = kk4;
      *(float4*)(s_w + i * 64 + kq * 4) = make_float4(ww[0], ww[1], ww[2], ww[3]);
      *(float4*)(s_b + i * 64 + kq * 4) = b4;
      *(float4*)(s_kd + i * 64 + kq * 4) = kd4;
      *(float4*)(s_r + i * 64 + kq * 4) = make_float4(rr[0], rr[1], rr[2], rr[3]);
      if ((kq >> 2) == rg) *(float4*)(s_v + i * 16 + (kq & 3) * 4) = make_float4(vv[0] * vmask, vv[1] * vmask, vv[2] * vmask, vv[3] * vmask);
    }
    __syncthreads();
    {
      const float* vb_ = s_kk + kq * 4;
      const float* vv_ = s_v + wv * 4 + rl;
      float4 kk4 = *(const float4*)(vb_), w4 = *(const float4*)(vb_ + TS * 64), b4 = *(const float4*)(vb_ + 2 * TS * 64);
      float4 kd4 = *(const float4*)(vb_ + 3 * TS * 64), r4 = *(const float4*)(vb_ + 4 * TS * 64);
      float vr = vv_[0];
      float* so_w = s_o + ((c0 / TS) & 1) * TS * 16;
#pragma unroll 4
      for (int i = 0; i < TS; ++i) {
        int in_ = (i + 1 < TS) ? i + 1 : i;
        float4 kk4n = *(const float4*)(vb_ + in_ * 64), w4n = *(const float4*)(vb_ + TS * 64 + in_ * 64), b4n = *(const float4*)(vb_ + 2 * TS * 64 + in_ * 64);
        float4 kd4n = *(const float4*)(vb_ + 3 * TS * 64 + in_ * 64), r4n = *(const float4*)(vb_ + 4 * TS * 64 + in_ * 64);
        float vrn = vv_[in_ * 16];
        float vx = __builtin_fmaf(S.x, w4.x, vr * kd4.x), vy = __builtin_fmaf(S.y, w4.y, vr * kd4.y);
        float vz = __builtin_fmaf(S.z, w4.z, vr * kd4.z), vw = __builtin_fmaf(S.w, w4.w, vr * kd4.w);
        float sk = __builtin_fmaf(S.z, kk4.z, S.x * kk4.x) + __builtin_fmaf(S.w, kk4.w, S.y * kk4.y);
        sk = row16_sum(sk);
        S.x = __builtin_fmaf(-sk, b4.x, vx); S.y = __builtin_fmaf(-sk, b4.y, vy);
        S.z = __builtin_fmaf(-sk, b4.z, vz); S.w = __builtin_fmaf(-sk, b4.w, vw);
        float o = S.x * r4.x + S.y * r4.y + S.z * r4.z + S.w * r4.w;
        o = row16_sum(o);
        so_w[i * 16 + wv * 4 + rl] = o;
        kk4 = kk4n; w4 = w4n; b4 = b4n; kd4 = kd4n; r4 = r4n; vr = vrn;
      }
    }
  };
  for (int c0 = sbeg; c0 < send; c0 += 2 * TS) {
#pragma unroll
    for (int n = 0; n < NSL; ++n) { int s = tid + 256 * n; if (s < NRT) *(uint4*)(raw + s * 8) = rgA[n]; }
    __syncthreads();
    if (c0 + 2 * TS < send) load_rawA(c0 + 2 * TS);
    rest(c0);
#pragma unroll
    for (int n = 0; n < NSL; ++n) { int s = tid + 256 * n; if (s < NRT) *(uint4*)(raw + s * 8) = rgB[n]; }
    __syncthreads();
    if (c0 + 3 * TS < send) load_rawB(c0 + 3 * TS);
    rest(c0 + TS);
  }
  __syncthreads();
  {
    const float* so = s_o + (((send / TS) - 1) & 1) * TS * 16;
    int i = tid >> 4, rr = tid & 15;
    int sidx = send - TS + i;
    int t = d ? (T - 1 - sidx) : sidx;
    obase[(size_t)(base + t) * old_ + rr] = f2bf(so[tid]);
  }
  if (unit == 3) {
    *(float4*)(p.out + OFF_RWKV + ((((size_t)(seq * 2 + l) * 2 + d) * 4 + h) * 64 + row) * 64 + kq * 4) = S;
  } else if (unit == 0) {
    *(float4*)(p.smid + ((size_t)ci * 64 + row) * 64 + kq * 4) = S;
  }
  __syncthreads();
}

DI unsigned pack_bf2(float lo, float hi) { return (unsigned)f2bf(lo) | ((unsigned)f2bf(hi) << 16); }
DI unsigned u4c(const uint4& v, int c) { return c == 0 ? v.x : (c == 1 ? v.y : (c == 2 ? v.z : v.w)); }
DI void ssd_item(const P& p, int l, int item, char* smemc) {
  const int tid = my_tid(), lane = tid & 63, wv = tid >> 6, r = lane & 15, q = lane >> 4;
  const bool latent = item < 48;
  const int cc = latent ? item : item - 48;
  const int sq = cc / 12, h = (cc % 12) >> 1, d = cc & 1, g = h / 3;
  const int base = latent ? (NCTX + sq * 4096) : (sq * 256);
  const int T = latent ? 4096 : 256;
  bf16_t* Cm = (bf16_t*)smemc;
  bf16_t* Bm = Cm + 64 * 72;
  bf16_t* XT = Bm + 64 * 72;
  bf16_t* BT = XT + 64 * 72;
  bf16_t* Ss = BT + 64 * 72;
  float* s_cs = (float*)(Ss + 64 * 72);
  float* s_dt = s_cs + 64;
  float* s_sc = s_dt + 64;
  float* s_cw = s_sc + 64;
  const float dtb = p.ssd_dt_bias[(l * 2 + d) * 6 + h];
  const float Aneg = -__expf(p.ssd_a_log[(l * 2 + d) * 6 + h]);
  for (int idx = tid; idx < 6 * 192; idx += 256) {
    int j = idx / 192, cq = idx - j * 192;
    int ch = (cq < 64) ? (h * 64 + cq) : ((cq < 128) ? (384 + g * 64 + (cq - 64)) : (512 + g * 64 + (cq - 128)));
    int jj = (j < 5 && d) ? (4 - j) : j;
    s_cw[idx] = (j < 5) ? p.ssd_conv_w[(l * 5 + jj) * 640 + ch] : p.ssd_conv_b[l * 640 + ch];
  }
  f32x4 S[4];
  const size_t st_off = (((size_t)(sq * 2 + l) * 2 + d) * 6 + h) * 4096;
#pragma unroll
  for (int nt = 0; nt < 4; ++nt)
#pragma unroll
    for (int e = 0; e < 4; ++e) {
      float v = latent ? p.state_ssd[st_off + (size_t)(wv * 16 + q * 4 + e) * 64 + nt * 16 + r] : 0.f;
      S[nt][e] = v;
      Ss[(wv * 16 + q * 4 + e) * 72 + nt * 16 + r] = f2bf(v);
    }
  const int sg = tid / 24, cg = tid - sg * 24;
  const int gcol = (cg < 8) ? (1024 + h * 64 + cg * 8) : ((cg < 16) ? (1024 + 384 + g * 64 + (cg - 8) * 8) : (1024 + 512 + g * 64 + (cg - 16) * 8));
  uint4 raw[12]; float dtraw = 0.f;
  auto load_raw = [&](int c0) {
    if (tid < 192) {
#pragma unroll
      for (int k = 0; k < 12; ++k) {
        int sidx = c0 + sg * 8 - 2 + k;
        bool ok = (sidx >= 0) && (sidx < T);
        int sc_ = ok ? sidx : 0;
        int t = d ? (T - 1 - sc_) : sc_;
        uint4 v = *(const uint4*)(p.proj + (size_t)(base + t) * PROJ_LD + gcol);
        raw[k] = ok ? v : make_uint4(0u, 0u, 0u, 0u);
      }
    } else {
      int sidx = c0 + lane;
      int t = d ? (T - 1 - sidx) : sidx;
      dtraw = bf2f(p.proj[(size_t)(base + t) * PROJ_LD + 1664 + d * 6 + h]);
    }
  };
  load_raw(0);
  __syncthreads();
  for (int c0 = 0; c0 < T; c0 += 64) {
    if (tid < 192) {
#pragma unroll
      for (int pc = 0; pc < 4; ++pc) {
        float in0[12], in1[12];
#pragma unroll
        for (int k = 0; k < 12; ++k) { unsigned u = u4c(raw[k], pc); in0[k] = __uint_as_float(u << 16); in1[k] = __uint_as_float(u & 0xffff0000u); }
        const int cq = cg * 8 + pc * 2;
        float w0[6], w1[6];
#pragma unroll
        for (int j = 0; j < 6; ++j) { float2 w = *(const float2*)(s_cw + j * 192 + cq); w0[j] = w.x; w1[j] = w.y; }
        float o0[8], o1[8];
#pragma unroll
        for (int s_ = 0; s_ < 8; ++s_) {
          float a0 = w0[5], a1 = w1[5];
#pragma unroll
          for (int j = 0; j < 5; ++j) { a0 += w0[j] * in0[s_ + j]; a1 += w1[j] * in1[s_ + j]; }
          o0[s_] = siluf_(a0); o1[s_] = siluf_(a1);
        }
        if (cg >= 8) {
          bf16_t* dstR = ((cg < 16) ? (Bm + (cg - 8) * 8) : (Cm + (cg - 16) * 8)) + pc * 2;
#pragma unroll
          for (int s_ = 0; s_ < 8; ++s_) *(unsigned*)(dstR + (sg * 8 + s_) * 72) = pack_bf2(o0[s_], o1[s_]);
        }
        if (cg < 16) {
          uint4 t0 = make_uint4(pack_bf2(o0[0], o0[1]), pack_bf2(o0[2], o0[3]), pack_bf2(o0[4], o0[5]), pack_bf2(o0[6], o0[7]));
          uint4 t1 = make_uint4(pack_bf2(o1[0], o1[1]), pack_bf2(o1[2], o1[3]), pack_bf2(o1[4], o1[5]), pack_bf2(o1[6], o1[7]));
          bf16_t* dstT = (cg < 8) ? (XT + (cg * 8 + pc * 2) * 72) : (BT + ((cg - 8) * 8 + pc * 2) * 72);
          *(uint4*)(dstT + sg * 8) = t0;
          *(uint4*)(dstT + 72 + sg * 8) = t1;
        }
      }
    } else {
      float dtr = dtraw + dtb;
      float dt = (dtr > 20.f) ? dtr : log1pf(__expf(dtr));
      float cs = Aneg * dt;
#pragma unroll
      for (int o = 1; o < 64; o <<= 1) { float v = __shfl_up(cs, o); if (lane >= o) cs += v; }
      float cs63 = __shfl(cs, 63);
      s_cs[lane] = cs; s_dt[lane] = dt; s_sc[lane] = __expf(cs63 - cs) * dt;
    }
    __syncthreads();
    {
      const int i0 = wv * 16;
      bf16x8 cf[2];
#pragma unroll
      for (int ks = 0; ks < 2; ++ks) cf[ks] = *(const bf16x8*)(Cm + (i0 + r) * 72 + ks * 32 + q * 8);
      f32x4 G[4];
#pragma unroll
      for (int jt = 0; jt < 4; ++jt) {
        G[jt] = (f32x4){0.f, 0.f, 0.f, 0.f};
#pragma unroll
        for (int ks = 0; ks < 2; ++ks) {
          bf16x8 bb = *(const bf16x8*)(Bm + (jt * 16 + r) * 72 + ks * 32 + q * 8);
          G[jt] = __builtin_amdgcn_mfma_f32_16x16x32_bf16(cf[ks], bb, G[jt], 0, 0, 0);
        }
      }
      float csi[4];
#pragma unroll
      for (int e = 0; e < 4; ++e) csi[e] = s_cs[i0 + q * 4 + e];
#pragma unroll
      for (int jt = 0; jt < 4; ++jt) {
        const int j = jt * 16 + r;
        const float csj = s_cs[j], dtj = s_dt[j];
#pragma unroll
        for (int e = 0; e < 4; ++e) {
          const int i = i0 + q * 4 + e;
          float dec = (j <= i) ? __expf(csi[e] - csj) * dtj : 0.f;
          Cm[(i0 + q * 4 + e) * 72 + jt * 16 + r] = f2bf(G[jt][e] * dec);
        }
      }
      bf16x8 mf[2];
#pragma unroll
      for (int ks = 0; ks < 2; ++ks) mf[ks] = *(const bf16x8*)(Cm + (i0 + r) * 72 + ks * 32 + q * 8);
      f32x4 Y[4];
#pragma unroll
      for (int pt = 0; pt < 4; ++pt) {
        Y[pt] = (f32x4){0.f, 0.f, 0.f, 0.f};
#pragma unroll
        for (int ks = 0; ks < 2; ++ks) {
          bf16x8 sb = *(const bf16x8*)(Ss + (pt * 16 + r) * 72 + ks * 32 + q * 8);
          Y[pt] = __builtin_amdgcn_mfma_f32_16x16x32_bf16(cf[ks], sb, Y[pt], 0, 0, 0);
        }
#pragma unroll
        for (int e = 0; e < 4; ++e) Y[pt][e] *= __expf(csi[e]);
#pragma unroll
        for (int ks = 0; ks < 2; ++ks) {
          bf16x8 xb = *(const bf16x8*)(XT + (pt * 16 + r) * 72 + ks * 32 + q * 8);
          Y[pt] = __builtin_amdgcn_mfma_f32_16x16x32_bf16(mf[ks], xb, Y[pt], 0, 0, 0);
        }
      }
#pragma unroll
      for (int e = 0; e < 4; ++e) {
        int sidx = c0 + i0 + q * 4 + e;
        int t = d ? (T - 1 - sidx) : sidx;
        bf16_t* od = p.outs + (size_t)(base + t) * OUTS_LD + 512 + d * 384 + h * 64 + r;
#pragma unroll
        for (int pt = 0; pt < 4; ++pt) od[pt * 16] = f2bf(Y[pt][e]);
      }
      if (c0 + 64 < T) load_raw(c0 + 64);
      const float dall = __expf(s_cs[63]);
      bf16x8 xa[2];
#pragma unroll
      for (int ks = 0; ks < 2; ++ks) {
        bf16x8 xr = *(const bf16x8*)(XT + (i0 + r) * 72 + ks * 32 + q * 8);
        float4 sA = *(const float4*)(s_sc + ks * 32 + q * 8), sB = *(const float4*)(s_sc + ks * 32 + q * 8 + 4);
        float scl[8] = {sA.x, sA.y, sA.z, sA.w, sB.x, sB.y, sB.z, sB.w};
#pragma unroll
        for (int jj = 0; jj < 8; ++jj) xa[ks][jj] = (short)f2bf(bf2f((bf16_t)xr[jj]) * scl[jj]);
      }
#pragma unroll
      for (int nt = 0; nt < 4; ++nt) {
#pragma unroll
        for (int e = 0; e < 4; ++e) S[nt][e] *= dall;
#pragma unroll
        for (int ks = 0; ks < 2; ++ks) {
          bf16x8 bt = *(const bf16x8*)(BT + (nt * 16 + r) * 72 + ks * 32 + q * 8);
          S[nt] = __builtin_amdgcn_mfma_f32_16x16x32_bf16(xa[ks], bt, S[nt], 0, 0, 0);
        }
      }
    }
    __syncthreads();
#pragma unroll
    for (int nt = 0; nt < 4; ++nt)
#pragma unroll
      for (int e = 0; e < 4; ++e) Ss[(wv * 16 + q * 4 + e) * 72 + nt * 16 + r] = f2bf(S[nt][e]);
  }
  if (!latent) {
#pragma unroll
    for (int nt = 0; nt < 4; ++nt)
#pragma unroll
      for (int e = 0; e < 4; ++e) p.out[OFF_SSD + st_off + (size_t)(wv * 16 + q * 4 + e) * 64 + nt * 16 + r] = S[nt][e];
  }
  __syncthreads();
}

DI void attn_item(const P& p, int l, int item, char* smemc) {
  const int tid = my_tid(), lane = tid & 63, wv = tid >> 6, r = lane & 15, q = lane >> 4;
  bool latent = item < 1536;
  int b, qb, head, base, T;
  if (latent) { b = item / 384; int rem = item % 384; qb = rem / 6; head = rem % 6; base = NCTX + b * 4096; T = 4096; }
  else { int it = item - 1536; b = it / 24; int rem = it % 24; qb = rem / 6; head = rem % 6; base = b * 256; T = 256; }
  const int kvh = head / 3;
  const int q0 = qb * 64;
  bf16_t* Ks = (bf16_t*)smemc;
  bf16_t* Vt = Ks + 64 * 72;
  bf16_t* Ps = Vt + 64 * 72 + wv * 16 * 72;
  bf16x8 Qf[2];
  {
    int qpos = q0 + wv * 16 + r;
    int qtok = base + qpos;
#pragma unroll
    for (int ks = 0; ks < 2; ++ks) {
      const bf16_t* src = p.proj + (size_t)qtok * PROJ_LD + head * 64 + ks * 32;
      uint4 own = *(const uint4*)(src + q * 8);
      bf16x8 o8 = __builtin_bit_cast(bf16x8, own);
      bf16x8 f;
      if (latent) {
        uint4 par = *(const uint4*)(src + (q ^ 2) * 8);
        bf16x8 p8 = __builtin_bit_cast(bf16x8, par);
        int pos = ks ? (qpos & 63) : (qpos >> 6);
        const float* rt = p.rope + (pos * 16 + (q & 1) * 8) * 2;
        float sgn = (q < 2) ? -1.f : 1.f;
#pragma unroll
        for (int j = 0; j < 8; ++j) {
          float cs = rt[j * 2], sn = rt[j * 2 + 1];
          float v = bf2f((bf16_t)o8[j]) * cs + sgn * bf2f((bf16_t)p8[j]) * sn;
          f[j] = (short)f2bf(v * 0.125f);
        }
      } else {
#pragma unroll
        for (int j = 0; j < 8; ++j) f[j] = (short)f2bf(bf2f((bf16_t)o8[j]) * 0.125f);
      }
      Qf[ks] = f;
    }
  }
  float m_[4], l_[4];
  f32x4 O[4];
  {
    float sk = p.attn_sink[l * 6 + head];
#pragma unroll
    for (int e = 0; e < 4; ++e) { m_[e] = sk; l_[e] = 1.f; }
#pragma unroll
    for (int dt = 0; dt < 4; ++dt) O[dt] = (f32x4){0.f, 0.f, 0.f, 0.f};
  }
  const int nloc = latent ? 5 : 4;
  const int ntile = latent ? 9 : 4;
  for (int ti = 0; ti < ntile; ++ti) {
    bool local = ti < nloc;
    int ts = 0;
    if (local) { ts = latent ? (q0 - 128 + 64 * ti) : 64 * ti; if (ts < 0 || ts >= T) continue; }
    else ts = (ti - nloc) * 64;
    {
      int key = tid >> 2, ch = tid & 3;
      {
        float vf[16];
        if (local) {
          const bf16_t* vsrc = p.proj + (size_t)(base + ts + key) * PROJ_LD + 512 + kvh * 64 + ch * 16;
          bf16x8 v0 = __builtin_bit_cast(bf16x8, *(const uint4*)(vsrc)), v1 = __builtin_bit_cast(bf16x8, *(const uint4*)(vsrc + 8));
#pragma unroll
          for (int j = 0; j < 8; ++j) { vf[j] = bf2f((bf16_t)v0[j]); vf[8 + j] = bf2f((bf16_t)v1[j]); }
        } else {
          const float* vsrc = p.cache_v + ((size_t)((b * 2 + l) * 256 + ts + key)) * 128 + kvh * 64 + ch * 16;
#pragma unroll
          for (int j4 = 0; j4 < 4; ++j4) { float4 c4 = ((const float4*)vsrc)[j4]; vf[j4 * 4] = c4.x; vf[j4 * 4 + 1] = c4.y; vf[j4 * 4 + 2] = c4.z; vf[j4 * 4 + 3] = c4.w; }
        }
#pragma unroll
        for (int j = 0; j < 16; ++j) Vt[(ch * 16 + j) * 72 + key] = f2bf(vf[j]);
      }
      asm volatile("" ::: "memory");
#pragma unroll
      for (int hf = 0; hf < 2; ++hf) {
        float kf[8];
        if (local) {
          const bf16_t* ksrc = p.proj + (size_t)(base + ts + key) * PROJ_LD + 384 + kvh * 64;
          bf16x8 k0 = __builtin_bit_cast(bf16x8, *(const uint4*)(ksrc + ch * 16 + hf * 8));
#pragma unroll
          for (int j = 0; j < 8; ++j) kf[j] = bf2f((bf16_t)k0[j]);
          if (latent) {
            bf16x8 p0 = __builtin_bit_cast(bf16x8, *(const uint4*)(ksrc + (ch ^ 1) * 16 + hf * 8));
            int kpos = ts + key;
            int pos = (ch >> 1) ? (kpos & 63) : (kpos >> 6);
            const float4* rt = (const float4*)(p.rope + pos * 32 + hf * 16);
            float sgn = (ch & 1) ? 1.f : -1.f;
#pragma unroll
            for (int j2 = 0; j2 < 4; ++j2) {
              float4 cs = rt[j2];
              kf[2 * j2] = kf[2 * j2] * cs.x + sgn * bf2f((bf16_t)p0[2 * j2]) * cs.y;
              kf[2 * j2 + 1] = kf[2 * j2 + 1] * cs.z + sgn * bf2f((bf16_t)p0[2 * j2 + 1]) * cs.w;
            }
          }
        } else {
          const float* ksrc = p.cache_k + ((size_t)((b * 2 + l) * 256 + ts + key)) * 128 + kvh * 64 + ch * 16 + hf * 8;
#pragma unroll
          for (int j4 = 0; j4 < 2; ++j4) { float4 a = ((const float4*)ksrc)[j4]; kf[j4 * 4] = a.x; kf[j4 * 4 + 1] = a.y; kf[j4 * 4 + 2] = a.z; kf[j4 * 4 + 3] = a.w; }
        }
        bf16x8 k8a;
#pragma unroll
        for (int j = 0; j < 8; ++j) k8a[j] = (short)f2bf(kf[j]);
        *(bf16x8*)(Ks + key * 72 + ch * 16 + hf * 8) = k8a;
        asm volatile("" ::: "memory");
      }
    }
    __syncthreads();
    {
      f32x4 S[4];
#pragma unroll
      for (int jt = 0; jt < 4; ++jt) {
        S[jt] = (f32x4){0.f, 0.f, 0.f, 0.f};
#pragma unroll
        for (int ks = 0; ks < 2; ++ks) {
          bf16x8 kb = *(const bf16x8*)(Ks + (jt * 16 + r) * 72 + ks * 32 + q * 8);
          S[jt] = __builtin_amdgcn_mfma_f32_16x16x32_bf16(Qf[ks], kb, S[jt], 0, 0, 0);
        }
      }
      if (local && latent) {
#pragma unroll
        for (int jt = 0; jt < 4; ++jt) {
          int kp = ts + jt * 16 + r;
#pragma unroll
          for (int e = 0; e < 4; ++e) {
            int qp = q0 + wv * 16 + q * 4 + e;
            int df = qp - kp; df = df < 0 ? -df : df;
            if (df > 128) S[jt][e] = -1e30f;
          }
        }
      }
#pragma unroll
      for (int e = 0; e < 4; ++e) {
        float mx = fmaxf(fmaxf(S[0][e], S[1][e]), fmaxf(S[2][e], S[3][e]));
        mx = row16_max(mx);
        float mn = fmaxf(m_[e], mx);
        float alpha = __expf(m_[e] - mn);
        m_[e] = mn;
        float rs = 0.f;
#pragma unroll
        for (int jt = 0; jt < 4; ++jt) { float pv = __expf(S[jt][e] - mn); S[jt][e] = pv; rs += pv; }
        rs = row16_sum(rs);
        l_[e] = l_[e] * alpha + rs;
#pragma unroll
        for (int dt = 0; dt < 4; ++dt) O[dt][e] *= alpha;
      }
#pragma unroll
      for (int jt = 0; jt < 4; ++jt)
#pragma unroll
        for (int e = 0; e < 4; ++e) Ps[(q * 4 + e) * 72 + jt * 16 + r] = f2bf(S[jt][e]);
      bf16x8 Pa[2];
#pragma unroll
      for (int ks = 0; ks < 2; ++ks) Pa[ks] = *(const bf16x8*)(Ps + r * 72 + ks * 32 + q * 8);
#pragma unroll
      for (int dt = 0; dt < 4; ++dt)
#pragma unroll
        for (int ks = 0; ks < 2; ++ks) {
          bf16x8 vb = *(const bf16x8*)(Vt + (dt * 16 + r) * 72 + ks * 32 + q * 8);
          O[dt] = __builtin_amdgcn_mfma_f32_16x16x32_bf16(Pa[ks], vb, O[dt], 0, 0, 0);
        }
    }
    __syncthreads();
  }
#pragma unroll
  for (int e = 0; e < 4; ++e) {
    float inv = 1.f / l_[e];
    int tok = base + q0 + wv * 16 + q * 4 + e;
#pragma unroll
    for (int dt = 0; dt < 4; ++dt)
      p.mixA[(size_t)tok * 384 + head * 64 + dt * 16 + r] = f2bf(O[dt][e] * inv);
  }
}

DI void rwkv_fix_phase(const P& p, int l, int bid, int nb) {
  const int tid = my_tid(), lane = tid & 63, wv = tid >> 6, r = lane & 15, q = lane >> 4;
  for (int item = bid; item < 32 * 32; item += nb) {
    const int ci = item >> 5, tile = item & 31;
    const int b = ci >> 3, h = (ci & 7) >> 1, d = ci & 1;
    const int base = NCTX + b * 4096, T = 4096;
    const int s0 = (T >> 1) + tile * 64 + wv * 16;
    bf16x8 af[2];
    {
      int sidx = s0 + r;
      int t = d ? (T - 1 - sidx) : sidx;
      const bf16_t* zp = p.proj + (size_t)(base + t) * PROJ_LD + RW0 + 768 + h * 64 + q * 8;
      af[0] = __builtin_bit_cast(bf16x8, *(const uint4*)(zp));
      af[1] = __builtin_bit_cast(bf16x8, *(const uint4*)(zp + 32));
    }
    f32x4 acc[4];
#pragma unroll
    for (int vt = 0; vt < 4; ++vt) {
      acc[vt] = (f32x4){0.f, 0.f, 0.f, 0.f};
#pragma unroll
      for (int ks = 0; ks < 2; ++ks) {
        const float* sp = p.smid + ((size_t)ci * 64 + vt * 16 + r) * 64 + ks * 32 + q * 8;
        float4 x0 = *(const float4*)(sp), x1 = *(const float4*)(sp + 4);
        bf16x8 bb;
        bb[0] = (short)f2bf(x0.x); bb[1] = (short)f2bf(x0.y); bb[2] = (short)f2bf(x0.z); bb[3] = (short)f2bf(x0.w);
        bb[4] = (short)f2bf(x1.x); bb[5] = (short)f2bf(x1.y); bb[6] = (short)f2bf(x1.z); bb[7] = (short)f2bf(x1.w);
        acc[vt] = __builtin_amdgcn_mfma_f32_16x16x32_bf16(af[ks], bb, acc[vt], 0, 0, 0);
      }
    }
#pragma unroll
    for (int e = 0; e < 4; ++e) {
      int sidx = s0 + q * 4 + e;
      int t = d ? (T - 1 - sidx) : sidx;
      bf16_t* op = p.outs + (size_t)(base + t) * OUTS_LD + d * 256 + h * 64 + r;
#pragma unroll
      for (int vt = 0; vt < 4; ++vt) op[vt * 16] = f2bf(bf2f(op[vt * 16]) + acc[vt][e]);
    }
  }
}

DI void mixers_phase(const P& p, int l, char* smem, int cidx) {
  __shared__ int s_item;
  const int n_rl = 384, n_sl = 48, n_rc = 512, n_sc = 192, n_al = 1536, n_ac = 384;
  const int n_mix = n_rl + n_sl + n_rc + n_sc + n_al + n_ac;
  const int total = n_mix + 2368;
  for (;;) {
    if (my_tid() == 0) s_item = (int)atomicAdd(&p.counters[cidx], 1u);
    __syncthreads();
    int it = s_item;
    __syncthreads();
    if (it >= total) { __builtin_amdgcn_s_setprio(0); break; }
    int kind, idx, rci = 0, rrg = 0, runit = 3;
    if (it < n_rl) { kind = 0; idx = it; runit = it >> 7; rci = (it & 127) >> 2; rrg = it & 3; }
    else if (it < n_rl + n_sl) { kind = 1; idx = it - n_rl; }
    else if (it < n_rl + n_sl + n_rc) { kind = 0; idx = it - n_rl - n_sl; rci = 32 + (idx >> 2); rrg = idx & 3; runit = 3; }
    else if (it < n_rl + n_sl + n_rc + n_sc) { kind = 1; idx = 48 + (it - n_rl - n_sl - n_rc); }
    else if (it < n_mix) { kind = 2; idx = it - (n_rl + n_sl + n_rc + n_sc); }
    else { kind = 3; idx = it - n_mix; }
    if (it < n_rl) __builtin_amdgcn_s_setprio(3); else if (it < n_rl + n_sl) __builtin_amdgcn_s_setprio(2); else __builtin_amdgcn_s_setprio(0);
    if (kind == 0) rwkv_item(p, l, rci, rrg, runit, smem);
    else if (kind == 1) ssd_item(p, l, idx, smem);
    else if (kind == 2) { attn_item(p, l, idx, smem); __syncthreads(); }
    else conv_rest_item(p, l, idx, (float*)smem);
  }
}

DI void combine_phase(const P& p, int l, int bid, int nb) {
  int wv = my_tid() >> 6, lane = my_tid() & 63;
  float cw[6][5], cb[6];
#pragma unroll
  for (int i = 0; i < 6; ++i) {
    cb[i] = p.ssd_conv_b[l * 640 + i * 64 + lane];
#pragma unroll
    for (int j = 0; j < 5; ++j) cw[i][j] = p.ssd_conv_w[(l * 5 + j) * 640 + i * 64 + lane];
  }
  for (int tok = bid * 4 + wv; tok < NTOK; tok += nb * 4) {
    int base, t, T, cj; tok_info(tok, base, t, T, cj);
    const bf16_t* os = p.outs + (size_t)tok * OUTS_LD;
    float ys[6]; float ssq = 0.f;
#pragma unroll
    for (int i = 0; i < 6; ++i) {
      if (i & 1) asm volatile("" ::: "memory");
      int ch = i * 64 + lane;
      float xs;
      {
        float acc_ = cb[i];
        const bf16_t* xp = p.proj + (size_t)tok * PROJ_LD + 1024 + ch;
#pragma unroll
        for (int j = 0; j < 5; ++j) {
          int tt = t + j - 2;
          bool ok = (tt >= 0) && (tt < T);
          float xv = bf2f(xp[ok ? (j - 2) * PROJ_LD : 0]);
          acc_ += ok ? cw[i][j] * xv : 0.f;
        }
        xs = siluf_(acc_);
      }
      float y = bf2f(os[512 + ch]) + bf2f(os[896 + ch]) + p.ssd_d[l * 6 + i] * xs;
      float z = bf2f(p.proj[(size_t)tok * PROJ_LD + 640 + ch]);
      y *= siluf_(z);
      ys[i] = y; ssq += y * y;
    }
    asm volatile("" ::: "memory");
    float rw[4];
#pragma unroll
    for (int hh = 0; hh < 4; ++hh) {
      asm volatile("" ::: "memory");
      int c = hh * 64 + lane;
      float o = bf2f(os[c]) + bf2f(os[256 + c]);
      float mu = wave_sum(o) * (1.f / 64.f);
      float dv = o - mu;
      float var = wave_sum(dv * dv) * (1.f / 64.f);
      o = dv * rsqrtf(var + 64e-5f) * p.rwkv_gn_w[l * 256 + c] + p.rwkv_gn_b[l * 256 + c];
      float rr = rw_mixed(p, l, tok, t, T, c), kx = rw_mixed(p, l, tok, t, T, 256 + c), vv = rw_mixed(p, l, tok, t, T, 512 + c);
      float a0 = bf2f(p.lr[(size_t)tok * LR_LD + 512 + c]), a1 = bf2f(p.lr[(size_t)tok * LR_LD + 768 + c]);
      float ka = p.rwkv_k_a[l * 256 + c];
      float kd = kx * (1.f + (a0 - 1.f) * ka) + kx * (1.f + (a1 - 1.f) * ka);
      float bsum = wave_sum(rr * kd * p.rwkv_r_k[l * 256 + c]);
      float gg = bf2f(p.lr[(size_t)tok * LR_LD + 1024 + c]);
      rw[hh] = (o + bsum * vv) * gg;
    }
    float rs = rsqrtf(wave_sum(ssq) * (1.f / 384.f) + 1e-5f);
    bf16_t* od = p.outs + (size_t)tok * OUTS_LD;
#pragma unroll
    for (int i = 0; i < 6; ++i) od[i * 64 + lane] = f2bf(ys[i] * rs * p.ssd_norm_w[l * 384 + i * 64 + lane]);
#pragma unroll
    for (int hh = 0; hh < 4; ++hh) od[384 + hh * 64 + lane] = f2bf(rw[hh]);
  }
}


#define XB_TMO      128
#define XB_XCNT(j)  (256  + 64 * (j))
#define XB_XSUB(j)  (1280 + 64 * (j))
#define XB_XGEN(j)  (2304 + 64 * (j))
#define XB_TOP      3328
#define XB_TOPGEN   3392
#define XCD_BAR_WORDS 3456
#define XB_SPIN_CAP (1u << 22)
#define LAS __attribute__((address_space(3)))
DI unsigned xb_ld(unsigned* p)              { return __hip_atomic_load(p, __ATOMIC_RELAXED, __HIP_MEMORY_SCOPE_AGENT); }
DI unsigned xb_add(unsigned* p, unsigned v) { return __hip_atomic_fetch_add(p, v, __ATOMIC_RELAXED, __HIP_MEMORY_SCOPE_AGENT); }
DI unsigned xb_xcc_id() { return (unsigned)__builtin_amdgcn_s_getreg((3 << 11) | 20) & 0xFu; }
#define XB_SPIN(cond, bar) do { unsigned _sp = 0; while (cond) { __builtin_amdgcn_s_sleep(1); \
    if ((++_sp & 255u) == 0u) { if (xb_ld(&(bar)[XB_TMO])) break; if (_sp > XB_SPIN_CAP) { atomicAdd(&(bar)[XB_TMO], 1u); break; } } } } while (0)
struct XcdBarrier { unsigned* bar; unsigned x; volatile LAS unsigned* st; };
DI XcdBarrier xcd_barrier_post(unsigned* bar, volatile LAS unsigned* st) {
  XcdBarrier b; b.bar = bar; b.x = xb_xcc_id(); b.st = st;
  if (threadIdx.x == 0) (void)xb_add(&bar[XB_XCNT(b.x)], 1u);
  return b;
}
DI void xcd_barrier_complete(unsigned* bar, unsigned x, unsigned& nloc, unsigned& nx) {
  const unsigned G = gridDim.x * gridDim.y * gridDim.z;
  unsigned sum, cnt, mine, sp = 0u;
  for (;;) {
    sum = 0u; cnt = 0u; mine = 0u;
#pragma unroll
    for (unsigned j = 0; j < 16; ++j) { const unsigned c = xb_ld(&bar[XB_XCNT(j)]); sum += c; cnt += (c > 0u) ? 1u : 0u; mine = (j == x) ? c : mine; }
    if (sum == G) break;
    __builtin_amdgcn_s_sleep(1);
    if ((++sp & 255u) == 0u) { if (xb_ld(&bar[XB_TMO])) break; if (sp > XB_SPIN_CAP) { atomicAdd(&bar[XB_TMO], 1u); break; } }
  }
  nloc = mine > 0u ? mine : 1u; nx = cnt > 0u ? cnt : 1u;
}
DI void xcd_barrier(const XcdBarrier& b) {
  asm volatile("s_waitcnt vmcnt(0)" ::: "memory");
  __syncthreads();
  if (threadIdx.x == 0) {
    unsigned* bar = b.bar;
    __builtin_amdgcn_s_waitcnt(0);
    unsigned nloc = b.st[0], nx = b.st[1];
    if (nloc == 0u) { xcd_barrier_complete(bar, b.x, nloc, nx); b.st[0] = nloc; b.st[1] = nx; }
    const unsigned old = xb_add(&bar[XB_XSUB(b.x)], 1u);
    const unsigned gen = old / nloc;
    if (old + 1u == (gen + 1u) * nloc) {
      __builtin_amdgcn_fence(__ATOMIC_RELEASE, "agent");
      asm volatile("s_waitcnt vmcnt(0)" ::: "memory");
      const unsigned og = xb_add(&bar[XB_TOP], 1u);
      const unsigned tg = og / nx;
      if (og + 1u == (tg + 1u) * nx) xb_add(&bar[XB_TOPGEN], 1u);
      else XB_SPIN(xb_ld(&bar[XB_TOPGEN]) == tg, bar);
      __builtin_amdgcn_fence(__ATOMIC_ACQUIRE, "agent");
      xb_add(&bar[XB_XGEN(b.x)], 1u);
      asm volatile("s_waitcnt vmcnt(0)" ::: "memory");
    } else {
      XB_SPIN(xb_ld(&bar[XB_XGEN(b.x)]) == gen, bar);
      __builtin_amdgcn_fence(__ATOMIC_ACQUIRE, "agent");
      asm volatile("s_waitcnt vmcnt(0)" ::: "memory");
    }
  }
  __syncthreads();
}

constexpr int NPHASE = 24;
DI void run_phase(const P& p, int ph, int bid, int nb, char* smem) {
  if (ph == 0) { phase0(p, bid, nb, (float*)smem); return; }
  if (ph == 23) { lnmod_phase(p, 2, 1, 0, -1, bid, nb); return; }
  int l = (ph - 1) / 11, s = (ph - 1) % 11;
  switch (s) {
    case 0:
      if (l == 0) lnmod_phase(p, 0, 0, 0, 0, bid, nb);
      else lnmod_phase(p, 2, 0, 1, 0, bid, nb);
      break;
    case 1: gemm_phase_dma256(p.hA, 1024, p.Win + (size_t)l * 2816 * 1024, 80, 22, 1024, Epi1{p, l}, bid, nb, smem); break;
    case 2: prepA_phase(p, l, bid, nb); break;
    case 3: gemm_phase_dma(p.Alr, 256, p.Alr, 256, 1 << 30, p.Wlr + (size_t)l * 1280 * 256, 160, 10, 256, EpiLR{p, l}, bid, nb, smem); break;
    case 4: mixers_phase(p, l, smem, l); break;
    case 5: rwkv_fix_phase(p, l, bid, nb); break;
    case 6: combine_phase(p, l, bid, nb); break;
    case 7: gemm_phase_dma(p.mixA, 384, p.outs, OUTS_LD, 384, p.Wout, 160, 8, 1024, EpiRes{p, l, 2048}, bid, nb, smem); break;
    case 8: lnmod_phase(p, 1, l, l, 3072, bid, nb); break;
    case 9: gemm_phase_dma256(p.hA, 1024, p.Wffi, 80, 44, 1024, EpiFfn{p}, bid, nb, smem); break;
    case 10: gemm_phase_dma(p.hidden, HID_LD, p.hidden, HID_LD, 1 << 30, p.Wffo, 160, 8, 2816, EpiRes{p, l, 5120}, bid, nb, smem); break;
  }
}

#if !MEGA
__global__ void __launch_bounds__(256, 2) k_phase(P p, int ph) {
  __shared__ __attribute__((aligned(16))) char smem[SMEM_BYTES];
  run_phase(p, ph, blockIdx.x, gridDim.x, smem);
}
#endif

#if MEGA
__global__ void __launch_bounds__(256, 2) k_mega(P p) {
  __shared__ __attribute__((aligned(16))) char smem[SMEM_BYTES];
  cg::grid_group grid = cg::this_grid();
  __shared__ uint4 xb_words;
  if (threadIdx.x == 0) xb_words = make_uint4(0u, 0u, 0u, 0u);
  __syncthreads();
  XcdBarrier xb = xcd_barrier_post(p.bar, (volatile LAS unsigned*)&xb_words);
#define RUNPH(PH) { int bidv = blockIdx.x, nbv = gridDim.x; asm volatile("" : "+s"(bidv), "+s"(nbv) :: "memory"); run_phase(p, PH, bidv, nbv, smem); }
  RUNPH(0); xcd_barrier(xb); if (p.out == nullptr) grid.sync();
  RUNPH(1); xcd_barrier(xb); RUNPH(2); xcd_barrier(xb); RUNPH(3); xcd_barrier(xb); RUNPH(4); xcd_barrier(xb); RUNPH(5); xcd_barrier(xb);
  RUNPH(6); xcd_barrier(xb); RUNPH(7); xcd_barrier(xb); RUNPH(8); xcd_barrier(xb); RUNPH(9); xcd_barrier(xb); RUNPH(10); xcd_barrier(xb);
  RUNPH(11); xcd_barrier(xb);
  RUNPH(12); xcd_barrier(xb); RUNPH(13); xcd_barrier(xb); RUNPH(14); xcd_barrier(xb); RUNPH(15); xcd_barrier(xb); RUNPH(16); xcd_barrier(xb);
  RUNPH(17); xcd_barrier(xb); RUNPH(18); xcd_barrier(xb); RUNPH(19); xcd_barrier(xb); RUNPH(20); xcd_barrier(xb); RUNPH(21); xcd_barrier(xb);
  RUNPH(22); xcd_barrier(xb);
  RUNPH(23);
}
#endif

extern "C" void kernel_launch(void* const* d_in, const int* in_sizes, int n_in, void* d_out, int out_size, void* d_ws, size_t ws_size,
                              hipStream_t stream) {
  P p{};
  const float** fp = (const float**)&p;
  for (int i = 0; i < 36; ++i) fp[i] = (const float*)d_in[i];
  p.out = (float*)d_out;
  char* ws = (char*)d_ws;
  size_t off = 0;
  auto take = [&](size_t bytes) { char* r = ws + off; off += (bytes + 255) & ~(size_t)255; return r; };
  p.mod = (float*)take(2 * 5 * 6144 * 4);
  p.rope = (float*)take(64 * 16 * 2 * 4);
  p.bar = (unsigned*)take(16384);
  p.counters = p.bar + XCD_BAR_WORDS;
  p.smid = (float*)take((size_t)32 * 4096 * 4);
  p.Wlr = (bf16_t*)take((size_t)2 * 1280 * 256 * 2);
  p.Win = (bf16_t*)take((size_t)2 * 2816 * 1024 * 2);
  p.Wout = (bf16_t*)take((size_t)1024 * 1024 * 2);
  p.Wffi = (bf16_t*)take((size_t)5632 * 1024 * 2);
  p.Wffo = (bf16_t*)take((size_t)1024 * 2816 * 2);
  p.proj = (bf16_t*)take((size_t)NTOK * PROJ_LD * 2);
  p.hidden = p.proj;
  p.lr = (bf16_t*)take((size_t)NTOK * LR_LD * 2);
  p.mixA = (bf16_t*)take((size_t)NTOK * 384 * 2);
  p.outs = (bf16_t*)take((size_t)NTOK * OUTS_LD * 2);
  p.Alr = p.outs;
  p.hA = p.outs;
  if (off > ws_size) { fprintf(stderr, "workspace too small: need %zu have %zu\n", off, ws_size); }
#if MEGA
  hipMemsetAsync(d_ws, 0, (size_t)((char*)p.bar - (char*)d_ws) + 16384, stream);
  static int grid_blocks = 0;
  if (!grid_blocks) {
    int dev = 0, cus = 0, per_cu = 0;
    hipGetDevice(&dev);
    hipDeviceGetAttribute(&cus, hipDeviceAttributeMultiprocessorCount, dev);
    hipOccupancyMaxActiveBlocksPerMultiprocessor(&per_cu, k_mega, 256, 0);
    if (per_cu > 2) per_cu = 2;
    grid_blocks = cus * per_cu;
  }
  void* args[] = {&p};
  hipError_t e = hipLaunchCooperativeKernel((void*)k_mega, dim3(grid_blocks), dim3(256), args, 0, stream);
  if (e != hipSuccess) fprintf(stderr, "cooperative launch failed: %s (grid %d)\n", hipGetErrorString(e), grid_blocks);
#else
  for (int ph = 0; ph < NPHASE; ++ph) k_phase<<<512, 256, 0, stream>>>(p, ph);
#endif
}
```

```cpp
#include <hip/hip_runtime.h>
#include <hip/hip_cooperative_groups.h>
#include <stdint.h>
#include <stdio.h>
namespace cg = cooperative_groups;

#ifndef MEGA
#define MEGA 1
#endif

#define DI __device__ __forceinline__
typedef __attribute__((ext_vector_type(8))) short bf16x8;
typedef __attribute__((ext_vector_type(4))) float f32x4;
typedef unsigned short bf16_t;

constexpr int NTOK = 20480, NCTX = 4096;
constexpr int PROJ_LD = 2704, LR_LD = 1280, OUTS_LD = 1280, HID_LD = 2816;
constexpr size_t OFF_K = 20971520, OFF_V = 22020096, OFF_SSD = 23068672, OFF_RWKV = 24641536;
constexpr int TS = 16;
constexpr int RW0 = 1680;
constexpr int SMEM_BYTES = 73728;

DI float bf2f(bf16_t h) { return __uint_as_float(((unsigned)h) << 16); }
DI bf16_t f2bf(float f) { unsigned u = __float_as_uint(f); u += 0x7fffu + ((u >> 16) & 1u); return (bf16_t)(u >> 16); }
DI float sigmoidf_(float x) { return 1.f / (1.f + __expf(-x)); }
DI float siluf_(float x) { return x / (1.f + __expf(-x)); }

template <int CTRL> DI float dpp_f(float x) {
  return __builtin_bit_cast(float, __builtin_amdgcn_update_dpp(0, __builtin_bit_cast(int, x), CTRL, 0xf, 0xf, false));
}
DI float row16_sum(float x) { x += dpp_f<0x128>(x); x += dpp_f<0x124>(x); x += dpp_f<0x122>(x); x += dpp_f<0x121>(x); return x; }
DI float row16_max(float x) { x = fmaxf(x, dpp_f<0x128>(x)); x = fmaxf(x, dpp_f<0x124>(x)); x = fmaxf(x, dpp_f<0x122>(x)); x = fmaxf(x, dpp_f<0x121>(x)); return x; }
DI float wave_sum(float x) { x = row16_sum(x); x += __shfl_xor(x, 16); x += __shfl_xor(x, 32); return x; }

DI int my_tid() { int t = threadIdx.x; asm volatile("" : "+v"(t)); return t; }

struct P {
  const float *x_prompt, *x_sample, *cache_k, *cache_v, *state_ssd, *state_rwkv, *c, *c_ctx;
  const float *w_mod, *b_mod, *w_in, *w_out, *attn_sink, *ssd_conv_w, *ssd_conv_b, *ssd_dt_bias, *ssd_a_log, *ssd_d, *ssd_norm_w;
  const float *rwkv_mu, *rwkv_w0, *rwkv_w_up, *rwkv_a0, *rwkv_a_up, *rwkv_g_up, *rwkv_k_k, *rwkv_k_a, *rwkv_r_k, *rwkv_gn_w, *rwkv_gn_b;
  const float *ln1_w, *ln1_b, *ln2_w, *ln2_b, *ffn_w_in, *ffn_w_out;
  float* out;
  float* mod;
  float* rope;
  unsigned* counters;
  unsigned* bar;
  float* smid;
  bf16_t *Wlr;
  bf16_t *Win;
  bf16_t *Wout;
  bf16_t *Wffi;
  bf16_t *Wffo;
  bf16_t *proj;
  bf16_t *hidden;
  bf16_t *lr;
  bf16_t *mixA;
  bf16_t *outs;
  bf16_t *Alr;
  bf16_t *hA;
};

DI void tok_info(int tok, int& base, int& t, int& T, int& cj) {
  if (tok < NCTX) { base = tok & ~255; t = tok & 255; T = 256; cj = 0; }
  else { int u = tok - NCTX; base = NCTX + (u & ~4095); t = u & 4095; T = 4096; cj = 1 + (u >> 12); }
}

DI void p0_mod(const P& p, int item, float* smem) {
  int kh = item & 1; item >>= 1;
  int l = item / 96, nbk = item % 96;
  int tid = my_tid(), lane = tid & 63, wv = tid >> 6;
  float* s_c = smem;
  for (int i = tid; i < 5 * 512; i += 256) {
    int j = i >> 9, k = kh * 512 + (i & 511);
    float v = (j == 0) ? p.c_ctx[k] : p.c[(j - 1) * 1024 + k];
    s_c[i] = siluf_(v);
  }
  __syncthreads();
  const float* W = p.w_mod + (size_t)l * 1024 * 6144 + (size_t)(kh * 512) * 6144 + nbk * 64 + lane;
  float a0 = 0, a1 = 0, a2 = 0, a3 = 0, a4 = 0;
  int k0 = wv * 128;
#pragma unroll 16
  for (int k = k0; k < k0 + 128; ++k) {
    float w = W[(size_t)k * 6144];
    a0 += s_c[k] * w; a1 += s_c[512 + k] * w; a2 += s_c[1024 + k] * w; a3 += s_c[1536 + k] * w; a4 += s_c[2048 + k] * w;
  }
  float* s_red = smem + 5 * 512;
  s_red[(wv * 5 + 0) * 64 + lane] = a0; s_red[(wv * 5 + 1) * 64 + lane] = a1; s_red[(wv * 5 + 2) * 64 + lane] = a2;
  s_red[(wv * 5 + 3) * 64 + lane] = a3; s_red[(wv * 5 + 4) * 64 + lane] = a4;
  __syncthreads();
  if (tid < 64) {
    float bm = kh ? 0.f : p.b_mod[l * 6144 + nbk * 64 + tid];
    for (int j = 0; j < 5; ++j) {
      float s = bm;
      for (int w = 0; w < 4; ++w) s += s_red[(w * 5 + j) * 64 + tid];
      atomicAdd(&p.mod[(size_t)(l * 5 + j) * 6144 + nbk * 64 + tid], s);
    }
  }
  __syncthreads();
}

DI void conv_tile(const float* __restrict__ src, int K, int N, bf16_t* __restrict__ dst, int kt, int nt, int mapmode, float* smem) {
  int tid = my_tid(), lane = tid & 63, wv = tid >> 6;
  int np = nt * 64 + lane;
  int ncol;
  if (mapmode == 0) ncol = (np < N) ? np : -1;
  else if (mapmode == 2) ncol = (np < 1676) ? np : ((np < 1680) ? -1 : ((np < 2704) ? np - 4 : -1));
  else { int blk = np >> 5, w = np & 31; ncol = (w < 16) ? (blk * 16 + w) : (2816 + blk * 16 + (w - 16)); }
  for (int i = wv; i < 64; i += 4) {
    float v = (ncol >= 0) ? src[(size_t)(kt * 64 + i) * N + ncol] : 0.f;
    smem[i * 65 + lane] = v;
  }
  __syncthreads();
  for (int i = wv; i < 64; i += 4) dst[(size_t)(nt * 64 + i) * K + kt * 64 + lane] = f2bf(smem[lane * 65 + i]);
  __syncthreads();
}

DI void conv_win_item(const P& p, int l, int it, float* smem) {
  conv_tile(p.w_in + (size_t)l * 1024 * 2700, 1024, 2700, p.Win + (size_t)l * 2816 * 1024, it % 16, it / 16, 2, smem);
}
DI void conv_rest_item(const P& p, int l, int it, float* smem) {
  if (it < 256) conv_tile(p.w_out + (size_t)l * 1024 * 1024, 1024, 1024, p.Wout, it % 16, it / 16, 0, smem);
  else if (it < 256 + 1408) { it -= 256; conv_tile(p.ffn_w_in + (size_t)l * 1024 * 5632, 1024, 5632, p.Wffi, it % 16, it / 16, 1, smem); }
  else { it -= 256 + 1408; conv_tile(p.ffn_w_out + (size_t)l * 2816 * 1024, 2816, 1024, p.Wffo, it % 44, it / 44, 0, smem); }
}
DI void wlr_item(const P& p, int it) {
  for (int e = it * 4096 + my_tid(); e < it * 4096 + 4096; e += 256) {
    int l = e / 327680, rem = e % 327680, n = rem >> 8, k = rem & 255;
    float v = 0.f;
    int c = n & 255;
    if (n < 512) { int d = n >> 8; if (k < 64) v = p.rwkv_w_up[((size_t)(l * 2 + d) * 64 + k) * 256 + c]; }
    else if (n < 1024) { int d = (n - 512) >> 8; if (k >= 64 && k < 128) v = p.rwkv_a_up[((size_t)(l * 2 + d) * 64 + (k - 64)) * 256 + c]; }
    else { if (k >= 128) v = p.rwkv_g_up[((size_t)l * 128 + (k - 128)) * 256 + c]; }
    p.Wlr[e] = f2bf(v);
  }
}
DI void phase0(const P& p, int bid, int nb, float* smem) {
  const int n_mod = 384, n_win = 1408, n_rest = 0, n_wlr = 160;
  const int total = n_mod + n_win + n_rest + n_wlr + 1;
  for (int it = bid; it < total; it += nb) {
    int i = it;
    if (i < n_mod) { p0_mod(p, i, smem); continue; } i -= n_mod;
    if (i < n_win) { conv_win_item(p, i / 704, i % 704, smem); continue; } i -= n_win;
    if (i < n_rest) { conv_rest_item(p, 0, i, smem); continue; } i -= n_rest;
    if (i < n_wlr) { wlr_item(p, i); continue; }
    for (int e = my_tid(); e < 1024; e += 256) {
      int pos = e >> 4, f = e & 15;
      float inv = 1.0f / powf(10000.0f, (float)(2 * f) / 32.0f);
      float ang = (float)pos * inv;
      p.rope[e * 2] = cosf(ang); p.rope[e * 2 + 1] = sinf(ang);
    }
  }
}

DI void lnmod_phase(const P& p, int ln_kind, int ln_l, int mod_l, int mod_off, int bid, int nb) {
  int wv = my_tid() >> 6, lane = my_tid() & 63;
  float4 lw[4], lb[4];
  if (ln_kind != 0) {
    const float* lwp = (ln_kind == 1 ? p.ln1_w : p.ln2_w) + ln_l * 1024;
    const float* lbp = (ln_kind == 1 ? p.ln1_b : p.ln2_b) + ln_l * 1024;
#pragma unroll
    for (int i = 0; i < 4; ++i) { lw[i] = ((const float4*)lwp)[lane + 64 * i]; lb[i] = ((const float4*)lbp)[lane + 64 * i]; }
  }
  auto srcp = [&](int tok) -> const float4* {
    return (const float4*)((ln_kind == 0) ? (tok < NCTX ? p.x_prompt + (size_t)tok * 1024 : p.x_sample + (size_t)(tok - NCTX) * 1024)
                                          : p.out + (size_t)tok * 1024);
  };
  const int stride = nb * 4;
  int tok = bid * 4 + wv;
  float4 vn[4];
  if (tok < NTOK) {
    const float4* sp = srcp(tok);
#pragma unroll
    for (int i = 0; i < 4; ++i) vn[i] = sp[lane + 64 * i];
  }
  for (; tok < NTOK; tok += stride) {
    float4 v[4];
#pragma unroll
    for (int i = 0; i < 4; ++i) v[i] = vn[i];
    if (tok + stride < NTOK) {
      const float4* sp = srcp(tok + stride);
#pragma unroll
      for (int i = 0; i < 4; ++i) vn[i] = sp[lane + 64 * i];
    }
    int base, t, T, cj; tok_info(tok, base, t, T, cj);
    float4 sh[4], sc[4];
    if (mod_off >= 0) {
      const float* md = p.mod + (size_t)(mod_l * 5 + cj) * 6144 + mod_off;
#pragma unroll
      for (int i = 0; i < 4; ++i) { sh[i] = ((const float4*)md)[lane + 64 * i]; sc[i] = ((const float4*)(md + 1024))[lane + 64 * i]; }
    }
    if (ln_kind != 0) {
      float s = 0;
#pragma unroll
      for (int i = 0; i < 4; ++i) s += v[i].x + v[i].y + v[i].z + v[i].w;
      float mu = wave_sum(s) * (1.f / 1024.f);
      float ss = 0;
#pragma unroll
      for (int i = 0; i < 4; ++i) { float a = v[i].x - mu, b = v[i].y - mu, c = v[i].z - mu, d = v[i].w - mu; ss += a * a + b * b + c * c + d * d; }
      float rs = rsqrtf(wave_sum(ss) * (1.f / 1024.f) + 1e-5f);
#pragma unroll
      for (int i = 0; i < 4; ++i) {
        v[i].x = (v[i].x - mu) * rs * lw[i].x + lb[i].x; v[i].y = (v[i].y - mu) * rs * lw[i].y + lb[i].y;
        v[i].z = (v[i].z - mu) * rs * lw[i].z + lb[i].z; v[i].w = (v[i].w - mu) * rs * lw[i].w + lb[i].w;
      }
    }
    float4* dst = (float4*)(p.out + (size_t)tok * 1024);
#pragma unroll
    for (int i = 0; i < 4; ++i) dst[lane + 64 * i] = v[i];
    if (mod_off >= 0) {
#pragma unroll
      for (int i = 0; i < 4; ++i) {
        ushort4 o;
        o.x = f2bf(v[i].x * (1.f + sc[i].x) + sh[i].x); o.y = f2bf(v[i].y * (1.f + sc[i].y) + sh[i].y);
        o.z = f2bf(v[i].z * (1.f + sc[i].z) + sh[i].z); o.w = f2bf(v[i].w * (1.f + sc[i].w) + sh[i].w);
        ((ushort4*)(p.hA + (size_t)tok * 1024))[lane + 64 * i] = o;
      }
    }
  }
}

template <class Epi>
DI void gemm_phase(const bf16_t* __restrict__ A0, int lda0, const bf16_t* __restrict__ A1, int lda1, int ksplit,
                   const bf16_t* __restrict__ B, int Mt, int Nt, int K, Epi epi, int bid, int nb, char* smem) {
  bf16_t* As = (bf16_t*)smem;
  bf16_t* Bs = As + 2 * 128 * 32;
  const int tid = my_tid(), lane = tid & 63, wv = tid >> 6, wm = wv >> 1, wn = wv & 1, r = lane & 15, q = lane >> 4;
  const int lrow = tid >> 2, lk = (tid & 3) * 8;
  const int lsw = (((tid & 3) ^ ((lrow >> 2) & 3)) * 8);
  const int fsw = ((q ^ ((r >> 2) & 3)) * 8);
  const int nk = K / 32;
  const int xcd = bid & 7, jb = bid >> 3, nbx = nb >> 3, mpx = Mt >> 3;
  const int ntx = mpx * Nt;
  for (int idx = jb; idx < ntx; idx += nbx) {
    const int g = idx / (4 * Nt), rem = idx - g * 4 * Nt;
    const int nt = rem >> 2, mt = xcd * mpx + g * 4 + (rem & 3);
    f32x4 acc[4][4];
#pragma unroll
    for (int i = 0; i < 4; ++i)
#pragma unroll
      for (int j = 0; j < 4; ++j) acc[i][j] = (f32x4){0.f, 0.f, 0.f, 0.f};
    uint4 a00, a01, b00, b01, a10, a11, b10, b11;
#define GLOAD(kt_, x0, x1, y0, y1) { int k0 = (kt_) * 32; const bf16_t* Ap = A0; int lda = lda0; int kk = k0; \
      if (k0 >= ksplit) { Ap = A1; lda = lda1; kk = k0 - ksplit; } \
      x0 = *(const uint4*)(Ap + (size_t)(mt * 128 + lrow) * lda + kk + lk); \
      x1 = *(const uint4*)(Ap + (size_t)(mt * 128 + lrow + 64) * lda + kk + lk); \
      y0 = *(const uint4*)(B + (size_t)(nt * 128 + lrow) * K + k0 + lk); \
      y1 = *(const uint4*)(B + (size_t)(nt * 128 + lrow + 64) * K + k0 + lk); }
#define LSTORE(buf_, x0, x1, y0, y1) { bf16_t* an = As + (buf_) * 128 * 32; bf16_t* bn = Bs + (buf_) * 128 * 32; \
      *(uint4*)(an + lrow * 32 + lsw) = x0; *(uint4*)(an + (lrow + 64) * 32 + lsw) = x1; \
      *(uint4*)(bn + lrow * 32 + lsw) = y0; *(uint4*)(bn + (lrow + 64) * 32 + lsw) = y1; }
    auto compute = [&](int buf) {
      const bf16_t* as = As + buf * 128 * 32;
      const bf16_t* bs = Bs + buf * 128 * 32;
      bf16x8 af[4], bfr[4];
#pragma unroll
      for (int i = 0; i < 4; ++i) af[i] = *(const bf16x8*)(as + (wm * 64 + i * 16 + r) * 32 + fsw);
#pragma unroll
      for (int j = 0; j < 4; ++j) bfr[j] = *(const bf16x8*)(bs + (wn * 64 + j * 16 + r) * 32 + fsw);
#pragma unroll
      for (int i = 0; i < 4; ++i)
#pragma unroll
        for (int j = 0; j < 4; ++j) acc[i][j] = __builtin_amdgcn_mfma_f32_16x16x32_bf16(af[i], bfr[j], acc[i][j], 0, 0, 0);
    };
    GLOAD(0, a00, a01, b00, b01);
    GLOAD(1, a10, a11, b10, b11);
    LSTORE(0, a00, a01, b00, b01);
    __syncthreads();
    for (int kt = 0; kt < nk; kt += 2) {
      if (kt + 2 < nk) GLOAD(kt + 2, a00, a01, b00, b01);
      compute(0);
      LSTORE(1, a10, a11, b10, b11);
      __syncthreads();
      if (kt + 3 < nk) GLOAD(kt + 3, a10, a11, b10, b11);
      compute(1);
      if (kt + 2 < nk) LSTORE(0, a00, a01, b00, b01);
      __syncthreads();
    }
    epi(acc, mt * 128 + wm * 64, nt * 128 + wn * 64, r, q);
  }
}

#define RAW_BARRIER() do { asm volatile("s_waitcnt lgkmcnt(0)" ::: "memory"); __builtin_amdgcn_s_barrier(); asm volatile("" ::: "memory"); } while (0)
template <class Epi>
DI void gemm_phase_dma(const bf16_t* __restrict__ A0, int lda0, const bf16_t* __restrict__ A1, int lda1, int ksplit,
                       const bf16_t* __restrict__ B, int Mt, int Nt, int K, Epi epi, int bid, int nb, char* smem) {
  bf16_t* Ls = (bf16_t*)smem;
  const int tid = my_tid(), lane = tid & 63, wv = tid >> 6, wm = wv >> 1, wn = wv & 1, r = lane & 15, q = lane >> 4;
  const int fsw = ((q ^ ((r >> 2) & 3)) * 8);
  const int lr_ = lane >> 2, ls_ = lane & 3;
  const int csrc = (ls_ ^ ((lr_ >> 2) & 3)) * 8;
  const int nk = K / 32;
  const int xcd = bid & 7, jb = bid >> 3, nbx = nb >> 3, mpx = Mt >> 3;
  const int ntx = mpx * Nt;
  const int wrow = __builtin_amdgcn_readfirstlane(wv) * 32;
  for (int idx = jb; idx < ntx; idx += nbx) {
    const int g = idx / (4 * Nt), rem = idx - g * 4 * Nt;
    const int nt = rem >> 2, mt = xcd * mpx + g * 4 + (rem & 3);
    f32x4 acc[4][4];
#pragma unroll
    for (int i = 0; i < 4; ++i)
#pragma unroll
      for (int j = 0; j < 4; ++j) acc[i][j] = (f32x4){0.f, 0.f, 0.f, 0.f};
    const size_t arow = (size_t)(mt * 128 + wrow + lr_);
    const bf16_t* bsrc = B + (size_t)(nt * 128 + wrow + lr_) * K + csrc;
    auto glds = [&](int kt, int st) {
      const int k0 = kt * 32;
      const bf16_t* Ap = A0; int lda = lda0; int kk = k0;
      if (k0 >= ksplit) { Ap = A1; lda = lda1; kk = k0 - ksplit; }
      const bf16_t* asrc = Ap + arow * lda + kk + csrc;
      bf16_t* la = Ls + st * 8192 + wrow * 32;
      __builtin_amdgcn_global_load_lds((const unsigned*)asrc, (__attribute__((address_space(3))) unsigned*)la, 16, 0, 0);
      __builtin_amdgcn_global_load_lds((const unsigned*)(asrc + (size_t)16 * lda), (__attribute__((address_space(3))) unsigned*)(la + 16 * 32), 16, 0, 0);
      bf16_t* lb = la + 4096;
      __builtin_amdgcn_global_load_lds((const unsigned*)(bsrc + k0), (__attribute__((address_space(3))) unsigned*)lb, 16, 0, 0);
      __builtin_amdgcn_global_load_lds((const unsigned*)(bsrc + (size_t)16 * K + k0), (__attribute__((address_space(3))) unsigned*)(lb + 16 * 32), 16, 0, 0);
    };
    const unsigned aaddr0 = (unsigned)(size_t)smem + (unsigned)(((wm * 64 + r) * 32 + fsw) * 2);
    const unsigned baddr0 = (unsigned)(size_t)smem + 8192u + (unsigned)(((wn * 64 + r) * 32 + fsw) * 2);
    auto compute = [&](int st) {
      bf16x8 af0, af1, af2, af3, bf0, bf1, bf2, bf3;
      const unsigned aa = aaddr0 + (unsigned)st * 16384u, ba = baddr0 + (unsigned)st * 16384u;
      asm volatile("ds_read_b128 %0, %8\n\tds_read_b128 %1, %8 offset:1024\n\tds_read_b128 %2, %8 offset:2048\n\tds_read_b128 %3, %8 offset:3072\n\t"
                   "ds_read_b128 %4, %9\n\tds_read_b128 %5, %9 offset:1024\n\tds_read_b128 %6, %9 offset:2048\n\tds_read_b128 %7, %9 offset:3072\n\t"
                   "s_waitcnt lgkmcnt(0)"
                   : "=&v"(af0), "=&v"(af1), "=&v"(af2), "=&v"(af3), "=&v"(bf0), "=&v"(bf1), "=&v"(bf2), "=&v"(bf3)
                   : "v"(aa), "v"(ba) : "memory");
#define MF(i_, a_) acc[i_][0] = __builtin_amdgcn_mfma_f32_16x16x32_bf16(a_, bf0, acc[i_][0], 0, 0, 0); \
                   acc[i_][1] = __builtin_amdgcn_mfma_f32_16x16x32_bf16(a_, bf1, acc[i_][1], 0, 0, 0); \
                   acc[i_][2] = __builtin_amdgcn_mfma_f32_16x16x32_bf16(a_, bf2, acc[i_][2], 0, 0, 0); \
                   acc[i_][3] = __builtin_amdgcn_mfma_f32_16x16x32_bf16(a_, bf3, acc[i_][3], 0, 0, 0);
      MF(0, af0) MF(1, af1) MF(2, af2) MF(3, af3)
#undef MF
    };
    asm volatile("s_waitcnt vmcnt(0)" ::: "memory");
    glds(0, 0);
    glds(1, 1);
    int st = 0, st2 = 2;
    for (int kt = 0; kt < nk; ++kt) {
      if (kt + 1 < nk) asm volatile("s_waitcnt vmcnt(4)" ::: "memory");
      else asm volatile("s_waitcnt vmcnt(0)" ::: "memory");
      RAW_BARRIER();
      if (kt + 2 < nk) glds(kt + 2, st2);
      compute(st);
      st = (st == 2) ? 0 : st + 1;
      st2 = (st2 == 2) ? 0 : st2 + 1;
    }
    RAW_BARRIER();
    epi(acc, mt * 128 + wm * 64, nt * 128 + wn * 64, r, q);
  }
}

template <class Epi>
DI void gemm_phase_dma256(const bf16_t* __restrict__ A, int lda, const bf16_t* __restrict__ B, int Mt, int Nt, int K, Epi epi, int bid, int nb, char* smem) {
  bf16_t* Ls = (bf16_t*)smem;
  const int tid = my_tid(), lane = tid & 63, wv = tid >> 6, wm = wv >> 1, wn = wv & 1, r = lane & 15, q = lane >> 4;
  const int fsw = ((q ^ ((r >> 2) & 3)) * 8);
  const int lr_ = lane >> 2, ls_ = lane & 3;
  const int csrc = (ls_ ^ ((lr_ >> 2) & 3)) * 8;
  const int nk = K / 32;
  const int xcd = bid & 7, jb = bid >> 3, nbx = nb >> 3, mpx = Mt >> 3;
  const int ntx = mpx * Nt;
  const int wvu = __builtin_amdgcn_readfirstlane(wv);
  const unsigned aaddr0 = (unsigned)(size_t)smem + (unsigned)(((wm * 128 + r) * 32 + fsw) * 2);
  const unsigned baddr0 = (unsigned)(size_t)smem + 16384u + (unsigned)(((wn * 64 + r) * 32 + fsw) * 2);
  for (int idx = jb; idx < ntx; idx += nbx) {
    const int g = idx / (2 * Nt), rem = idx - g * 2 * Nt;
    const int nt = rem >> 1, mt = xcd * mpx + g * 2 + (rem & 1);
    f32x4 accA[4][4], accB[4][4];
#pragma unroll
    for (int i = 0; i < 4; ++i)
#pragma unroll
      for (int j = 0; j < 4; ++j) { accA[i][j] = (f32x4){0.f, 0.f, 0.f, 0.f}; accB[i][j] = (f32x4){0.f, 0.f, 0.f, 0.f}; }
    const bf16_t* asrc = A + (size_t)(mt * 256 + wvu * 64 + lr_) * lda + csrc;
    const bf16_t* bsrc = B + (size_t)(nt * 128 + wvu * 32 + lr_) * K + csrc;
    auto glds = [&](int kt, int st) {
      const int k0 = kt * 32;
      bf16_t* la = Ls + st * 12288 + wvu * 64 * 32;
#pragma unroll
      for (int u = 0; u < 4; ++u)
        __builtin_amdgcn_global_load_lds((const unsigned*)(asrc + (size_t)(u * 16) * lda + k0), (__attribute__((address_space(3))) unsigned*)(la + u * 16 * 32), 16, 0, 0);
      bf16_t* lb = Ls + st * 12288 + 8192 + wvu * 32 * 32;
#pragma unroll
      for (int u = 0; u < 2; ++u)
        __builtin_amdgcn_global_load_lds((const unsigned*)(bsrc + (size_t)(u * 16) * K + k0), (__attribute__((address_space(3))) unsigned*)(lb + u * 16 * 32), 16, 0, 0);
    };
    auto compute = [&](int st) {
      bf16x8 af0, af1, af2, af3, bf0, bf1, bf2, bf3;
      const unsigned aa = aaddr0 + (unsigned)st * 24576u, ba = baddr0 + (unsigned)st * 24576u;
      asm volatile("ds_read_b128 %0, %8\n\tds_read_b128 %1, %8 offset:1024\n\tds_read_b128 %2, %8 offset:2048\n\tds_read_b128 %3, %8 offset:3072\n\t"
                   "ds_read_b128 %4, %9\n\tds_read_b128 %5, %9 offset:1024\n\tds_read_b128 %6, %9 offset:2048\n\tds_read_b128 %7, %9 offset:3072\n\t"
                   "s_waitcnt lgkmcnt(0)"
                   : "=&v"(af0), "=&v"(af1), "=&v"(af2), "=&v"(af3), "=&v"(bf0), "=&v"(bf1), "=&v"(bf2), "=&v"(bf3)
                   : "v"(aa), "v"(ba) : "memory");
#define MF(acc_, i_, a_) acc_[i_][0] = __builtin_amdgcn_mfma_f32_16x16x32_bf16(a_, bf0, acc_[i_][0], 0, 0, 0); \
                         acc_[i_][1] = __builtin_amdgcn_mfma_f32_16x16x32_bf16(a_, bf1, acc_[i_][1], 0, 0, 0); \
                         acc_[i_][2] = __builtin_amdgcn_mfma_f32_16x16x32_bf16(a_, bf2, acc_[i_][2], 0, 0, 0); \
                         acc_[i_][3] = __builtin_amdgcn_mfma_f32_16x16x32_bf16(a_, bf3, acc_[i_][3], 0, 0, 0);
      MF(accA, 0, af0) MF(accA, 1, af1) MF(accA, 2, af2) MF(accA, 3, af3)
      bf16x8 ag0, ag1, ag2, ag3;
      asm volatile("ds_read_b128 %0, %4 offset:4096\n\tds_read_b128 %1, %4 offset:5120\n\tds_read_b128 %2, %4 offset:6144\n\tds_read_b128 %3, %4 offset:7168\n\t"
                   "s_waitcnt lgkmcnt(0)"
                   : "=&v"(ag0), "=&v"(ag1), "=&v"(ag2), "=&v"(ag3) : "v"(aa) : "memory");
      MF(accB, 0, ag0) MF(accB, 1, ag1) MF(accB, 2, ag2) MF(accB, 3, ag3)
#undef MF
    };
    asm volatile("s_waitcnt vmcnt(0)" ::: "memory");
    glds(0, 0);
    glds(1, 1);
    int st = 0, st2 = 2;
    for (int kt = 0; kt < nk; ++kt) {
      if (kt + 1 < nk) asm volatile("s_waitcnt vmcnt(6)" ::: "memory");
      else asm volatile("s_waitcnt vmcnt(0)" ::: "memory");
      RAW_BARRIER();
      if (kt + 2 < nk) glds(kt + 2, st2);
      compute(st);
      __builtin_amdgcn_sched_barrier(0);
      st = (st == 2) ? 0 : st + 1;
      st2 = (st2 == 2) ? 0 : st2 + 1;
    }
    RAW_BARRIER();
    epi(accA, mt * 256 + wm * 128, nt * 128 + wn * 64, r, q);
    asm volatile("" ::: "memory");
    __builtin_amdgcn_sched_barrier(0);
    epi(accB, mt * 256 + wm * 128 + 64, nt * 128 + wn * 64, r, q);
  }
}

struct Epi1 {
  const P& p; int l;
  DI void operator()(f32x4 (&acc)[4][4], int m0, int n0, int r, int q) const {
#pragma unroll
    for (int i = 0; i < 4; ++i)
#pragma unroll
      for (int e = 0; e < 4; ++e) {
        int row = m0 + i * 16 + q * 4 + e;
        asm volatile("" : "+v"(row));
        bf16_t* pr = p.proj + (size_t)row * PROJ_LD + n0 + r;
#pragma unroll
        for (int j = 0; j < 4; ++j) if (n0 + j * 16 + r < PROJ_LD) pr[j * 16] = f2bf(acc[i][j][e]);
      }
    if (m0 < NCTX && n0 >= 384 && n0 < 640) {
      float* cb = p.out + ((n0 < 512) ? OFF_K : OFF_V) + ((n0 - 384) & 127) + r;
#pragma unroll
      for (int i = 0; i < 4; ++i)
#pragma unroll
        for (int e = 0; e < 4; ++e) {
          int row = m0 + i * 16 + q * 4 + e;
          asm volatile("" : "+v"(row));
          float* cr = cb + ((size_t)((row >> 8) * 2 + l) * 256 + (row & 255)) * 128;
#pragma unroll
          for (int j = 0; j < 4; ++j) cr[j * 16] = acc[i][j][e];
        }
    }
  }
};
struct EpiLR {
  const P& p; int l;
  DI void operator()(f32x4 (&acc)[4][4], int m0, int n0, int r, int q) const {
#pragma unroll
    for (int i = 0; i < 4; ++i)
#pragma unroll
      for (int j = 0; j < 4; ++j) {
        int col = n0 + j * 16 + r;
        float bias = 0.f; bool sg = false;
        if (col < 512) { bias = p.rwkv_w0[l * 512 + col]; sg = true; }
        else if (col < 1024) { bias = p.rwkv_a0[l * 512 + (col - 512)]; sg = true; }
#pragma unroll
        for (int e = 0; e < 4; ++e) {
          int row = m0 + i * 16 + q * 4 + e;
          float v = acc[i][j][e] + bias;
          if (sg) v = sigmoidf_(v);
          p.lr[(size_t)row * LR_LD + col] = f2bf(v);
        }
      }
  }
};
struct EpiRes {
  const P& p; int l; int gate_off;
  DI void operator()(f32x4 (&acc)[4][4], int m0, int n0, int r, int q) const {
    int base, t, T, cj; tok_info(m0, base, t, T, cj);
    const float* g = p.mod + (size_t)(l * 5 + cj) * 6144 + gate_off;
#pragma unroll
    for (int i = 0; i < 4; ++i)
#pragma unroll
      for (int j = 0; j < 4; ++j) {
        int col = n0 + j * 16 + r;
        float gv = g[col];
#pragma unroll
        for (int e = 0; e < 4; ++e) {
          int row = m0 + i * 16 + q * 4 + e;
          float* xp = p.out + (size_t)row * 1024 + col;
          *xp = 1.41421356237f * (*xp) + gv * acc[i][j][e];
        }
      }
  }
};
struct EpiFfn {
  const P& p;
  DI void operator()(f32x4 (&acc)[4][4], int m0, int n0, int r, int q) const {
#pragma unroll
    for (int i = 0; i < 4; ++i)
#pragma unroll
      for (int jp = 0; jp < 4; jp += 2) {
        int hc = ((n0 + jp * 16) >> 1) + r;
#pragma unroll
        for (int e = 0; e < 4; ++e) {
          int row = m0 + i * 16 + q * 4 + e;
          asm volatile("" : "+v"(row));
          float g = acc[i][jp][e], u = acc[i][jp + 1][e];
          p.hidden[(size_t)row * HID_LD + hc] = f2bf(siluf_(g) * u);
        }
      }
  }
};

DI float rw_mixed(const P& p, int l, int tok, int t, int T, int col) {
  const bf16_t* pr = p.proj + (size_t)tok * PROJ_LD + RW0 + col;
  float pc = bf2f(pr[0]);
  float pm = bf2f(pr[(t > 0) ? -PROJ_LD : 0]);
  float pn = bf2f(pr[(t < T - 1) ? PROJ_LD : 0]);
  pm = (t > 0) ? pm : 0.f; pn = (t < T - 1) ? pn : 0.f;
  float mu = p.rwkv_mu[l * 1024 + col];
  return pc + mu * (0.5f * (pm + pn) - pc);
}
DI float ssd_conv(const P& p, int l, int base, int t, int T, int ch) {
  float acc = p.ssd_conv_b[l * 640 + ch];
  float xv[5], wv_[5];
#pragma unroll
  for (int j = 0; j < 5; ++j) {
    int tt = t + j - 2;
    int tc = tt < 0 ? 0 : (tt > T - 1 ? T - 1 : tt);
    xv[j] = bf2f(p.proj[(size_t)(base + tc) * PROJ_LD + 1024 + ch]);
    wv_[j] = p.ssd_conv_w[(l * 5 + j) * 640 + ch];
  }
#pragma unroll
  for (int j = 0; j < 5; ++j) { int tt = t + j - 2; acc += (tt >= 0 && tt < T) ? wv_[j] * xv[j] : 0.f; }
  return siluf_(acc);
}

DI void prepA_phase(const P& p, int l, int bid, int nb) {
  const int j = my_tid();
  const float mu = p.rwkv_mu[l * 1024 + 768 + j];
  for (int tok0 = bid * 8; tok0 < NTOK; tok0 += nb * 8) {
    int base, t0, T, cj; tok_info(tok0, base, t0, T, cj);
    float v[10];
#pragma unroll
    for (int i = 0; i < 10; ++i) {
      int t = t0 - 1 + i;
      v[i] = (t >= 0 && t < T) ? bf2f(p.proj[(size_t)(base + t) * PROJ_LD + RW0 + 768 + j]) : 0.f;
    }
#pragma unroll
    for (int i = 0; i < 8; ++i) {
      float m = v[i + 1] + mu * (0.5f * (v[i] + v[i + 2]) - v[i + 1]);
      float o = (j < 64) ? tanhf(m) : ((j < 128) ? m : sigmoidf_(m));
      p.Alr[(size_t)(tok0 + i) * 256 + j] = f2bf(o);
    }
  }
}

DI void unpack4(uint2 u, float (&f)[4]) {
  f[0] = __uint_as_float(u.x << 16); f[1] = __uint_as_float(u.x & 0xffff0000u);
  f[2] = __uint_as_float(u.y << 16); f[3] = __uint_as_float(u.y & 0xffff0000u);
}
DI void rwkv_item(const P& p, int l, int ci, int rg, int unit, char* smemc) {
  const int tid = my_tid(), lane = tid & 63, wv = tid >> 6;
  int seq, h = (ci & 7) >> 1, d = ci & 1, base, T;
  bool latent = ci < 32;
  if (latent) { int b = ci >> 3; seq = b; base = NCTX + b * 4096; T = 4096; }
  else { int s = (ci - 32) >> 3; seq = s; base = s * 256; T = 256; }
  float* s_kk = (float*)smemc; float* s_w = s_kk + TS * 64; float* s_b = s_w + TS * 64; float* s_kd = s_b + TS * 64; float* s_r = s_kd + TS * 64;
  float* s_v = s_r + TS * 64; float* s_o = s_v + TS * 16;
  bf16_t* raw = (bf16_t*)(s_o + 2 * TS * 16);
  bf16_t* rawlr = raw + (TS + 2) * 192;
  const int rl = lane >> 4, kq = lane & 15;
  const int row = rg * 16 + wv * 4 + rl;
  const int sbeg = (unit == 1 || unit == 2) ? (T >> 1) : 0;
  const int send = (unit == 0) ? (T >> 1) : T;
  float4 S;
  if (unit == 0) S = *(const float4*)(p.state_rwkv + ((((size_t)(seq * 2 + l) * 2 + d) * 4 + h) * 64 + row) * 64 + kq * 4);
  else if (unit == 2) S = make_float4((kq * 4 + 0 == row) ? 1.f : 0.f, (kq * 4 + 1 == row) ? 1.f : 0.f, (kq * 4 + 2 == row) ? 1.f : 0.f, (kq * 4 + 3 == row) ? 1.f : 0.f);
  else S = make_float4(0.f, 0.f, 0.f, 0.f);
  const float vmask = (unit == 2) ? 0.f : 1.f;
  bf16_t* const obase = (unit == 2) ? (p.proj + RW0 + 768 + h * 64 + rg * 16) : (p.outs + d * 256 + h * 64 + rg * 16);
  const int old_ = (unit == 2) ? PROJ_LD : OUTS_LD;
  float mu_r[4], mu_k[4], mu_v[4], k_k[4], k_a[4];
#pragma unroll
  for (int e = 0; e < 4; ++e) {
    int c = h * 64 + kq * 4 + e;
    mu_r[e] = p.rwkv_mu[l * 1024 + c]; mu_k[e] = p.rwkv_mu[l * 1024 + 256 + c]; mu_v[e] = p.rwkv_mu[l * 1024 + 512 + c];
    k_k[e] = p.rwkv_k_k[l * 256 + c]; k_a[e] = p.rwkv_k_a[l * 256 + c];
  }
  constexpr int NRK = (TS + 2) * 24, NRT = NRK + TS * 16, NSL = (NRT + 255) / 256;
  uint4 rgA[NSL], rgB[NSL];
  auto load_rawA = [&](int c0) {
#pragma unroll
    for (int n = 0; n < NSL; ++n) {
      int s = tid + 256 * n;
      const uint4* src = nullptr;
      if (s < NRK) {
        int rw_ = s / 24, rem = s - rw_ * 24;
        int sidx = c0 - 1 + rw_;
        if (sidx >= 0 && sidx < T) {
          int t = d ? (T - 1 - sidx) : sidx;
          src = (const uint4*)(p.proj + (size_t)(base + t) * PROJ_LD + RW0 + (rem >> 3) * 256 + h * 64 + (rem & 7) * 8);
        }
      } else if (s < NRT) {
        int s2 = s - NRK;
        int i = s2 >> 4, rem = s2 & 15;
        int sidx = c0 + i;
        int t = d ? (T - 1 - sidx) : sidx;
        src = (const uint4*)(p.lr + (size_t)(base + t) * LR_LD + (rem >> 3) * 512 + d * 256 + h * 64 + (rem & 7) * 8);
      }
      rgA[n] = src ? *src : make_uint4(0u, 0u, 0u, 0u);
    }
  };
  auto load_rawB = [&](int c0) {
#pragma unroll
    for (int n = 0; n < NSL; ++n) {
      int s = tid + 256 * n;
      const uint4* src = nullptr;
      if (s < NRK) {
        int rw_ = s / 24, rem = s - rw_ * 24;
        int sidx = c0 - 1 + rw_;
        if (sidx >= 0 && sidx < T) {
          int t = d ? (T - 1 - sidx) : sidx;
          src = (const uint4*)(p.proj + (size_t)(base + t) * PROJ_LD + RW0 + (rem >> 3) * 256 + h * 64 + (rem & 7) * 8);
        }
      } else if (s < NRT) {
        int s2 = s - NRK;
        int i = s2 >> 4, rem = s2 & 15;
        int sidx = c0 + i;
        int t = d ? (T - 1 - sidx) : sidx;
        src = (const uint4*)(p.lr + (size_t)(base + t) * LR_LD + (rem >> 3) * 512 + d * 256 + h * 64 + (rem & 7) * 8);
      }
      rgB[n] = src ? *src : make_uint4(0u, 0u, 0u, 0u);
    }
  };
  asm volatile("" :: "v"(mu_r[0]), "v"(mu_r[1]), "v"(mu_r[2]), "v"(mu_r[3]), "v"(mu_k[0]), "v"(mu_k[1]), "v"(mu_k[2]), "v"(mu_k[3]),
               "v"(mu_v[0]), "v"(mu_v[1]), "v"(mu_v[2]), "v"(mu_v[3]), "v"(k_k[0]), "v"(k_k[1]), "v"(k_k[2]), "v"(k_k[3]),
               "v"(k_a[0]), "v"(k_a[1]), "v"(k_a[2]), "v"(k_a[3]), "v"(S.x), "v"(S.y), "v"(S.z), "v"(S.w));
  load_rawA(sbeg);
  load_rawB(sbeg + TS);
  auto rest = [&](int c0) {
    if (c0 > sbeg) {
      const float* so = s_o + (((c0 / TS) - 1) & 1) * TS * 16;
      int i = tid >> 4, rr = tid & 15;
      int sidx = c0 - TS + i;
      int t = d ? (T - 1 - sidx) : sidx;
      obase[(size_t)(base + t) * old_ + rr] = f2bf(so[tid]);
    }
#pragma unroll
    for (int pp = 0; pp < TS / 16; ++pp) {
      int i = pp * 16 + wv * 4 + rl;
      const bf16_t* rc = raw + (i + 1) * 192 + kq * 4;
      float rC[4], rM[4], rN[4], kC[4], kM[4], kN[4], vC[4], vM[4], vN[4], sw[4], aa[4];
      unpack4(*(const uint2*)(rc), rC); unpack4(*(const uint2*)(rc - 192), rM); unpack4(*(const uint2*)(rc + 192), rN);
      unpack4(*(const uint2*)(rc + 64), kC); unpack4(*(const uint2*)(rc + 64 - 192), kM); unpack4(*(const uint2*)(rc + 64 + 192), kN);
      unpack4(*(const uint2*)(rc + 128), vC); unpack4(*(const uint2*)(rc + 128 - 192), vM); unpack4(*(const uint2*)(rc + 128 + 192), vN);
      unpack4(*(const uint2*)(rawlr + i * 128 + kq * 4), sw); unpack4(*(const uint2*)(rawlr + i * 128 + 64 + kq * 4), aa);
      float rr[4], kx[4], vv[4], kkr[4], ww[4];
      float ssq = 0.f;
#pragma unroll
      for (int e = 0; e < 4; ++e) {
        rr[e] = rC[e] + mu_r[e] * (0.5f * (rM[e] + rN[e]) - rC[e]);
        kx[e] = kC[e] + mu_k[e] * (0.5f * (kM[e] + kN[e]) - kC[e]);
        vv[e] = vC[e] + mu_v[e] * (0.5f * (vM[e] + vN[e]) - vC[e]);
        ww[e] = __expf(-0.6065306597126334f * sw[e]);
        kkr[e] = kx[e] * k_k[e];
        ssq += kkr[e] * kkr[e];
      }
      ssq = row16_sum(ssq);
      float inv = rsqrtf(ssq + 1e-12f);
      float4 kk4, b4, kd4;
      kk4.x = kkr[0] * inv; kk4.y = kkr[1] * inv; kk4.z = kkr[2] * inv; kk4.w = kkr[3] * inv;
      b4.x = kk4.x * aa[0]; b4.y = kk4.y * aa[1]; b4.z = kk4.z * aa[2]; b4.w = kk4.w * aa[3];
      kd4.x = kx[0] * (1.f + (aa[0] - 1.f) * k_a[0]); kd4.y = kx[1] * (1.f + (aa[1] - 1.f) * k_a[1]);
      kd4.z = kx[2] * (1.f + (aa[2] - 1.f) * k_a[2]); kd4.w = kx[3] * (1.f + (aa[3] - 1.f) * k_a[3]);
      *(float4*)(s_kk + i * 64 + kq * 4) = kk4;
      *(float4*)(s_w + i * 64 + kq * 4) = make_float4(ww[0], ww[1], ww[2], ww[3]);
      *(float4*)(s_b + i * 64 + kq * 4) = b4;
      *(float4*)(s_kd + i * 64 + kq * 4) = kd4;
      *(float4*)(s_r + i * 64 + kq * 4) = make_float4(rr[0], rr[1], rr[2], rr[3]);
      if ((kq >> 2) == rg) *(float4*)(s_v + i * 16 + (kq & 3) * 4) = make_float4(vv[0] * vmask, vv[1] * vmask, vv[2] * vmask, vv[3] * vmask);
    }
    __syncthreads();
    {
      const float* vb_ = s_kk + kq * 4;
      const float* vv_ = s_v + wv * 4 + rl;
      float4 kk4 = *(const float4*)(vb_), w4 = *(const float4*)(vb_ + TS * 64), b4 = *(const float4*)(vb_ + 2 * TS * 64);
      float4 kd4 = *(const float4*)(vb_ + 3 * TS * 64), r4 = *(const float4*)(vb_ + 4 * TS * 64);
      float vr = vv_[0];
      float* so_w = s_o + ((c0 / TS) & 1) * TS * 16;
#pragma unroll 4
      for (int i = 0; i < TS; ++i) {
        int in_ = (i + 1 < TS) ? i + 1 : i;
        float4 kk4n = *(const float4*)(vb_ + in_ * 64), w4n = *(const float4*)(vb_ + TS * 64 + in_ * 64), b4n = *(const float4*)(vb_ + 2 * TS * 64 + in_ * 64);
        float4 kd4n = *(const float4*)(vb_ + 3 * TS * 64 + in_ * 64), r4n = *(const float4*)(vb_ + 4 * TS * 64 + in_ * 64);
        float vrn = vv_[in_ * 16];
        float vx = __builtin_fmaf(S.x, w4.x, vr * kd4.x), vy = __builtin_fmaf(S.y, w4.y, vr * kd4.y);
        float vz = __builtin_fmaf(S.z, w4.z, vr * kd4.z), vw = __builtin_fmaf(S.w, w4.w, vr * kd4.w);
        float sk = __builtin_fmaf(S.z, kk4.z, S.x * kk4.x) + __builtin_fmaf(S.w, kk4.w, S.y * kk4.y);
        sk = row16_sum(sk);
        S.x = __builtin_fmaf(-sk, b4.x, vx); S.y = __builtin_fmaf(-sk, b4.y, vy);
        S.z = __builtin_fmaf(-sk, b4.z, vz); S.w = __builtin_fmaf(-sk, b4.w, vw);
        float o = S.x * r4.x + S.y * r4.y + S.z * r4.z + S.w * r4.w;
        o = row16_sum(o);
        so_w[i * 16 + wv * 4 + rl] = o;
        kk4 = kk4n; w4 = w4n; b4 = b4n; kd4 = kd4n; r4 = r4n; vr = vrn;
      }
    }
  };
  for (int c0 = sbeg; c0 < send; c0 += 2 * TS) {
#pragma unroll
    for (int n = 0; n < NSL; ++n) { int s = tid + 256 * n; if (s < NRT) *(uint4*)(raw + s * 8) = rgA[n]; }
    __syncthreads();
    if (c0 + 2 * TS < send) load_rawA(c0 + 2 * TS);
    rest(c0);
#pragma unroll
    for (int n = 0; n < NSL; ++n) { int s = tid + 256 * n; if (s < NRT) *(uint4*)(raw + s * 8) = rgB[n]; }
    __syncthreads();
    if (c0 + 3 * TS < send) load_rawB(c0 + 3 * TS);
    rest(c0 + TS);
  }
  __syncthreads();
  {
    const float* so = s_o + (((send / TS) - 1) & 1) * TS * 16;
    int i = tid >> 4, rr = tid & 15;
    int sidx = send - TS + i;
    int t = d ? (T - 1 - sidx) : sidx;
    obase[(size_t)(base + t) * old_ + rr] = f2bf(so[tid]);
  }
  if (unit == 3) {
    *(float4*)(p.out + OFF_RWKV + ((((size_t)(seq * 2 + l) * 2 + d) * 4 + h) * 64 + row) * 64 + kq * 4) = S;
  } else if (unit == 0) {
    *(float4*)(p.smid + ((size_t)ci * 64 + row) * 64 + kq * 4) = S;
  }
  __syncthreads();
}

DI unsigned pack_bf2(float lo, float hi) { return (unsigned)f2bf(lo) | ((unsigned)f2bf(hi) << 16); }
DI unsigned u4c(const uint4& v, int c) { return c == 0 ? v.x : (c == 1 ? v.y : (c == 2 ? v.z : v.w)); }
DI void ssd_item(const P& p, int l, int item, char* smemc) {
  const int tid = my_tid(), lane = tid & 63, wv = tid >> 6, r = lane & 15, q = lane >> 4;
  const bool latent = item < 48;
  const int cc = latent ? item : item - 48;
  const int sq = cc / 12, h = (cc % 12) >> 1, d = cc & 1, g = h / 3;
  const int base = latent ? (NCTX + sq * 4096) : (sq * 256);
  const int T = latent ? 4096 : 256;
  bf16_t* Cm = (bf16_t*)smemc;
  bf16_t* Bm = Cm + 64 * 72;
  bf16_t* XT = Bm + 64 * 72;
  bf16_t* BT = XT + 64 * 72;
  bf16_t* Ss = BT + 64 * 72;
  float* s_cs = (float*)(Ss + 64 * 72);
  float* s_dt = s_cs + 64;
  float* s_sc = s_dt + 64;
  float* s_cw = s_sc + 64;
  const float dtb = p.ssd_dt_bias[(l * 2 + d) * 6 + h];
  const float Aneg = -__expf(p.ssd_a_log[(l * 2 + d) * 6 + h]);
  for (int idx = tid; idx < 6 * 192; idx += 256) {
    int j = idx / 192, cq = idx - j * 192;
    int ch = (cq < 64) ? (h * 64 + cq) : ((cq < 128) ? (384 + g * 64 + (cq - 64)) : (512 + g * 64 + (cq - 128)));
    int jj = (j < 5 && d) ? (4 - j) : j;
    s_cw[idx] = (j < 5) ? p.ssd_conv_w[(l * 5 + jj) * 640 + ch] : p.ssd_conv_b[l * 640 + ch];
  }
  f32x4 S[4];
  const size_t st_off = (((size_t)(sq * 2 + l) * 2 + d) * 6 + h) * 4096;
#pragma unroll
  for (int nt = 0; nt < 4; ++nt)
#pragma unroll
    for (int e = 0; e < 4; ++e) {
      float v = latent ? p.state_ssd[st_off + (size_t)(wv * 16 + q * 4 + e) * 64 + nt * 16 + r] : 0.f;
      S[nt][e] = v;
      Ss[(wv * 16 + q * 4 + e) * 72 + nt * 16 + r] = f2bf(v);
    }
  const int sg = tid / 24, cg = tid - sg * 24;
  const int gcol = (cg < 8) ? (1024 + h * 64 + cg * 8) : ((cg < 16) ? (1024 + 384 + g * 64 + (cg - 8) * 8) : (1024 + 512 + g * 64 + (cg - 16) * 8));
  uint4 raw[12]; float dtraw = 0.f;
  auto load_raw = [&](int c0) {
    if (tid < 192) {
#pragma unroll
      for (int k = 0; k < 12; ++k) {
        int sidx = c0 + sg * 8 - 2 + k;
        bool ok = (sidx >= 0) && (sidx < T);
        int sc_ = ok ? sidx : 0;
        int t = d ? (T - 1 - sc_) : sc_;
        uint4 v = *(const uint4*)(p.proj + (size_t)(base + t) * PROJ_LD + gcol);
        raw[k] = ok ? v : make_uint4(0u, 0u, 0u, 0u);
      }
    } else {
      int sidx = c0 + lane;
      int t = d ? (T - 1 - sidx) : sidx;
      dtraw = bf2f(p.proj[(size_t)(base + t) * PROJ_LD + 1664 + d * 6 + h]);
    }
  };
  load_raw(0);
  __syncthreads();
  for (int c0 = 0; c0 < T; c0 += 64) {
    if (tid < 192) {
#pragma unroll
      for (int pc = 0; pc < 4; ++pc) {
        float in0[12], in1[12];
#pragma unroll
        for (int k = 0; k < 12; ++k) { unsigned u = u4c(raw[k], pc); in0[k] = __uint_as_float(u << 16); in1[k] = __uint_as_float(u & 0xffff0000u); }
        const int cq = cg * 8 + pc * 2;
        float w0[6], w1[6];
#pragma unroll
        for (int j = 0; j < 6; ++j) { float2 w = *(const float2*)(s_cw + j * 192 + cq); w0[j] = w.x; w1[j] = w.y; }
        float o0[8], o1[8];
#pragma unroll
        for (int s_ = 0; s_ < 8; ++s_) {
          float a0 = w0[5], a1 = w1[5];
#pragma unroll
          for (int j = 0; j < 5; ++j) { a0 += w0[j] * in0[s_ + j]; a1 += w1[j] * in1[s_ + j]; }
          o0[s_] = siluf_(a0); o1[s_] = siluf_(a1);
        }
        if (cg >= 8) {
          bf16_t* dstR = ((cg < 16) ? (Bm + (cg - 8) * 8) : (Cm + (cg - 16) * 8)) + pc * 2;
#pragma unroll
          for (int s_ = 0; s_ < 8; ++s_) *(unsigned*)(dstR + (sg * 8 + s_) * 72) = pack_bf2(o0[s_], o1[s_]);
        }
        if (cg < 16) {
          uint4 t0 = make_uint4(pack_bf2(o0[0], o0[1]), pack_bf2(o0[2], o0[3]), pack_bf2(o0[4], o0[5]), pack_bf2(o0[6], o0[7]));
          uint4 t1 = make_uint4(pack_bf2(o1[0], o1[1]), pack_bf2(o1[2], o1[3]), pack_bf2(o1[4], o1[5]), pack_bf2(o1[6], o1[7]));
          bf16_t* dstT = (cg < 8) ? (XT + (cg * 8 + pc * 2) * 72) : (BT + ((cg - 8) * 8 + pc * 2) * 72);
          *(uint4*)(dstT + sg * 8) = t0;
          *(uint4*)(dstT + 72 + sg * 8) = t1;
        }
      }
    } else {
      float dtr = dtraw + dtb;
      float dt = (dtr > 20.f) ? dtr : log1pf(__expf(dtr));
      float cs = Aneg * dt;
#pragma unroll
      for (int o = 1; o < 64; o <<= 1) { float v = __shfl_up(cs, o); if (lane >= o) cs += v; }
      float cs63 = __shfl(cs, 63);
      s_cs[lane] = cs; s_dt[lane] = dt; s_sc[lane] = __expf(cs63 - cs) * dt;
    }
    __syncthreads();
    {
      const int i0 = wv * 16;
      bf16x8 cf[2];
#pragma unroll
      for (int ks = 0; ks < 2; ++ks) cf[ks] = *(const bf16x8*)(Cm + (i0 + r) * 72 + ks * 32 + q * 8);
      f32x4 G[4];
#pragma unroll
      for (int jt = 0; jt < 4; ++jt) {
        G[jt] = (f32x4){0.f, 0.f, 0.f, 0.f};
#pragma unroll
        for (int ks = 0; ks < 2; ++ks) {
          bf16x8 bb = *(const bf16x8*)(Bm + (jt * 16 + r) * 72 + ks * 32 + q * 8);
          G[jt] = __builtin_amdgcn_mfma_f32_16x16x32_bf16(cf[ks], bb, G[jt], 0, 0, 0);
        }
      }
      float csi[4];
#pragma unroll
      for (int e = 0; e < 4; ++e) csi[e] = s_cs[i0 + q * 4 + e];
#pragma unroll
      for (int jt = 0; jt < 4; ++jt) {
        const int j = jt * 16 + r;
        const float csj = s_cs[j], dtj = s_dt[j];
#pragma unroll
        for (int e = 0; e < 4; ++e) {
          const int i = i0 + q * 4 + e;
          float dec = (j <= i) ? __expf(csi[e] - csj) * dtj : 0.f;
          Cm[(i0 + q * 4 + e) * 72 + jt * 16 + r] = f2bf(G[jt][e] * dec);
        }
      }
      bf16x8 mf[2];
#pragma unroll
      for (int ks = 0; ks < 2; ++ks) mf[ks] = *(const bf16x8*)(Cm + (i0 + r) * 72 + ks * 32 + q * 8);
      f32x4 Y[4];
#pragma unroll
      for (int pt = 0; pt < 4; ++pt) {
        Y[pt] = (f32x4){0.f, 0.f, 0.f, 0.f};
#pragma unroll
        for (int ks = 0; ks < 2; ++ks) {
          bf16x8 sb = *(const bf16x8*)(Ss + (pt * 16 + r) * 72 + ks * 32 + q * 8);
          Y[pt] = __builtin_amdgcn_mfma_f32_16x16x32_bf16(cf[ks], sb, Y[pt], 0, 0, 0);
        }
#pragma unroll
        for (int e = 0; e < 4; ++e) Y[pt][e] *= __expf(csi[e]);
#pragma unroll
        for (int ks = 0; ks < 2; ++ks) {
          bf16x8 xb = *(const bf16x8*)(XT + (pt * 16 + r) * 72 + ks * 32 + q * 8);
          Y[pt] = __builtin_amdgcn_mfma_f32_16x16x32_bf16(mf[ks], xb, Y[pt], 0, 0, 0);
        }
      }
#pragma unroll
      for (int e = 0; e < 4; ++e) {
        int sidx = c0 + i0 + q * 4 + e;
        int t = d ? (T - 1 - sidx) : sidx;
        bf16_t* od = p.outs + (size_t)(base + t) * OUTS_LD + 512 + d * 384 + h * 64 + r;
#pragma unroll
        for (int pt = 0; pt < 4; ++pt) od[pt * 16] = f2bf(Y[pt][e]);
      }
      if (c0 + 64 < T) load_raw(c0 + 64);
      const float dall = __expf(s_cs[63]);
      bf16x8 xa[2];
#pragma unroll
      for (int ks = 0; ks < 2; ++ks) {
        bf16x8 xr = *(const bf16x8*)(XT + (i0 + r) * 72 + ks * 32 + q * 8);
        float4 sA = *(const float4*)(s_sc + ks * 32 + q * 8), sB = *(const float4*)(s_sc + ks * 32 + q * 8 + 4);
        float scl[8] = {sA.x, sA.y, sA.z, sA.w, sB.x, sB.y, sB.z, sB.w};
#pragma unroll
        for (int jj = 0; jj < 8; ++jj) xa[ks][jj] = (short)f2bf(bf2f((bf16_t)xr[jj]) * scl[jj]);
      }
#pragma unroll
      for (int nt = 0; nt < 4; ++nt) {
#pragma unroll
        for (int e = 0; e < 4; ++e) S[nt][e] *= dall;
#pragma unroll
        for (int ks = 0; ks < 2; ++ks) {
          bf16x8 bt = *(const bf16x8*)(BT + (nt * 16 + r) * 72 + ks * 32 + q * 8);
          S[nt] = __builtin_amdgcn_mfma_f32_16x16x32_bf16(xa[ks], bt, S[nt], 0, 0, 0);
        }
      }
    }
    __syncthreads();
#pragma unroll
    for (int nt = 0; nt < 4; ++nt)
#pragma unroll
      for (int e = 0; e < 4; ++e) Ss[(wv * 16 + q * 4 + e) * 72 + nt * 16 + r] = f2bf(S[nt][e]);
  }
  if (!latent) {
#pragma unroll
    for (int nt = 0; nt < 4; ++nt)
#pragma unroll
      for (int e = 0; e < 4; ++e) p.out[OFF_SSD + st_off + (size_t)(wv * 16 + q * 4 + e) * 64 + nt * 16 + r] = S[nt][e];
  }
  __syncthreads();
}

DI void attn_item(const P& p, int l, int item, char* smemc) {
  const int tid = my_tid(), lane = tid & 63, wv = tid >> 6, r = lane & 15, q = lane >> 4;
  bool latent = item < 1536;
  int b, qb, head, base, T;
  if (latent) { b = item / 384; int rem = item % 384; qb = rem / 6; head = rem % 6; base = NCTX + b * 4096; T = 4096; }
  else { int it = item - 1536; b = it / 24; int rem = it % 24; qb = rem / 6; head = rem % 6; base = b * 256; T = 256; }
  const int kvh = head / 3;
  const int q0 = qb * 64;
  bf16_t* Ks = (bf16_t*)smemc;
  bf16_t* Vt = Ks + 64 * 72;
  bf16_t* Ps = Vt + 64 * 72 + wv * 16 * 72;
  bf16x8 Qf[2];
  {
    int qpos = q0 + wv * 16 + r;
    int qtok = base + qpos;
#pragma unroll
    for (int ks = 0; ks < 2; ++ks) {
      const bf16_t* src = p.proj + (size_t)qtok * PROJ_LD + head * 64 + ks * 32;
      uint4 own = *(const uint4*)(src + q * 8);
      bf16x8 o8 = __builtin_bit_cast(bf16x8, own);
      bf16x8 f;
      if (latent) {
        uint4 par = *(const uint4*)(src + (q ^ 2) * 8);
        bf16x8 p8 = __builtin_bit_cast(bf16x8, par);
        int pos = ks ? (qpos & 63) : (qpos >> 6);
        const float* rt = p.rope + (pos * 16 + (q & 1) * 8) * 2;
        float sgn = (q < 2) ? -1.f : 1.f;
#pragma unroll
        for (int j = 0; j < 8; ++j) {
          float cs = rt[j * 2], sn = rt[j * 2 + 1];
          float v = bf2f((bf16_t)o8[j]) * cs + sgn * bf2f((bf16_t)p8[j]) * sn;
          f[j] = (short)f2bf(v * 0.125f);
        }
      } else {
#pragma unroll
        for (int j = 0; j < 8; ++j) f[j] = (short)f2bf(bf2f((bf16_t)o8[j]) * 0.125f);
      }
      Qf[ks] = f;
    }
  }
  float m_[4], l_[4];
  f32x4 O[4];
  {
    float sk = p.attn_sink[l * 6 + head];
#pragma unroll
    for (int e = 0; e < 4; ++e) { m_[e] = sk; l_[e] = 1.f; }
#pragma unroll
    for (int dt = 0; dt < 4; ++dt) O[dt] = (f32x4){0.f, 0.f, 0.f, 0.f};
  }
  const int nloc = latent ? 5 : 4;
  const int ntile = latent ? 9 : 4;
  for (int ti = 0; ti < ntile; ++ti) {
    bool local = ti < nloc;
    int ts = 0;
    if (local) { ts = latent ? (q0 - 128 + 64 * ti) : 64 * ti; if (ts < 0 || ts >= T) continue; }
    else ts = (ti - nloc) * 64;
    {
      int key = tid >> 2, ch = tid & 3;
      {
        float vf[16];
        if (local) {
          const bf16_t* vsrc = p.proj + (size_t)(base + ts + key) * PROJ_LD + 512 + kvh * 64 + ch * 16;
          bf16x8 v0 = __builtin_bit_cast(bf16x8, *(const uint4*)(vsrc)), v1 = __builtin_bit_cast(bf16x8, *(const uint4*)(vsrc + 8));
#pragma unroll
          for (int j = 0; j < 8; ++j) { vf[j] = bf2f((bf16_t)v0[j]); vf[8 + j] = bf2f((bf16_t)v1[j]); }
        } else {
          const float* vsrc = p.cache_v + ((size_t)((b * 2 + l) * 256 + ts + key)) * 128 + kvh * 64 + ch * 16;
#pragma unroll
          for (int j4 = 0; j4 < 4; ++j4) { float4 c4 = ((const float4*)vsrc)[j4]; vf[j4 * 4] = c4.x; vf[j4 * 4 + 1] = c4.y; vf[j4 * 4 + 2] = c4.z; vf[j4 * 4 + 3] = c4.w; }
        }
#pragma unroll
        for (int j = 0; j < 16; ++j) Vt[(ch * 16 + j) * 72 + key] = f2bf(vf[j]);
      }
      asm volatile("" ::: "memory");
#pragma unroll
      for (int hf = 0; hf < 2; ++hf) {
        float kf[8];
        if (local) {
          const bf16_t* ksrc = p.proj + (size_t)(base + ts + key) * PROJ_LD + 384 + kvh * 64;
          bf16x8 k0 = __builtin_bit_cast(bf16x8, *(const uint4*)(ksrc + ch * 16 + hf * 8));
#pragma unroll
          for (int j = 0; j < 8; ++j) kf[j] = bf2f((bf16_t)k0[j]);
          if (latent) {
            bf16x8 p0 = __builtin_bit_cast(bf16x8, *(const uint4*)(ksrc + (ch ^ 1) * 16 + hf * 8));
            int kpos = ts + key;
            int pos = (ch >> 1) ? (kpos & 63) : (kpos >> 6);
            const float4* rt = (const float4*)(p.rope + pos * 32 + hf * 16);
            float sgn = (ch & 1) ? 1.f : -1.f;
#pragma unroll
            for (int j2 = 0; j2 < 4; ++j2) {
              float4 cs = rt[j2];
              kf[2 * j2] = kf[2 * j2] * cs.x + sgn * bf2f((bf16_t)p0[2 * j2]) * cs.y;
              kf[2 * j2 + 1] = kf[2 * j2 + 1] * cs.z + sgn * bf2f((bf16_t)p0[2 * j2 + 1]) * cs.w;
            }
          }
        } else {
          const float* ksrc = p.cache_k + ((size_t)((b * 2 + l) * 256 + ts + key)) * 128 + kvh * 64 + ch * 16 + hf * 8;
#pragma unroll
          for (int j4 = 0; j4 < 2; ++j4) { float4 a = ((const float4*)ksrc)[j4]; kf[j4 * 4] = a.x; kf[j4 * 4 + 1] = a.y; kf[j4 * 4 + 2] = a.z; kf[j4 * 4 + 3] = a.w; }
        }
        bf16x8 k8a;
#pragma unroll
        for (int j = 0; j < 8; ++j) k8a[j] = (short)f2bf(kf[j]);
        *(bf16x8*)(Ks + key * 72 + ch * 16 + hf * 8) = k8a;
        asm volatile("" ::: "memory");
      }
    }
    __syncthreads();
    {
      f32x4 S[4];
#pragma unroll
      for (int jt = 0; jt < 4; ++jt) {
        S[jt] = (f32x4){0.f, 0.f, 0.f, 0.f};
#pragma unroll
        for (int ks = 0; ks < 2; ++ks) {
          bf16x8 kb = *(const bf16x8*)(Ks + (jt * 16 + r) * 72 + ks * 32 + q * 8);
          S[jt] = __builtin_amdgcn_mfma_f32_16x16x32_bf16(Qf[ks], kb, S[jt], 0, 0, 0);
        }
      }
      if (local && latent) {
#pragma unroll
        for (int jt = 0; jt < 4; ++jt) {
          int kp = ts + jt * 16 + r;
#pragma unroll
          for (int e = 0; e < 4; ++e) {
            int qp = q0 + wv * 16 + q * 4 + e;
            int df = qp - kp; df = df < 0 ? -df : df;
            if (df > 128) S[jt][e] = -1e30f;
          }
        }
      }
#pragma unroll
      for (int e = 0; e < 4; ++e) {
        float mx = fmaxf(fmaxf(S[0][e], S[1][e]), fmaxf(S[2][e], S[3][e]));
        mx = row16_max(mx);
        float mn = fmaxf(m_[e], mx);
        float alpha = __expf(m_[e] - mn);
        m_[e] = mn;
        float rs = 0.f;
#pragma unroll
        for (int jt = 0; jt < 4; ++jt) { float pv = __expf(S[jt][e] - mn); S[jt][e] = pv; rs += pv; }
        rs = row16_sum(rs);
        l_[e] = l_[e] * alpha + rs;
#pragma unroll
        for (int dt = 0; dt < 4; ++dt) O[dt][e] *= alpha;
      }
#pragma unroll
      for (int jt = 0; jt < 4; ++jt)
#pragma unroll
        for (int e = 0; e < 4; ++e) Ps[(q * 4 + e) * 72 + jt * 16 + r] = f2bf(S[jt][e]);
      bf16x8 Pa[2];
#pragma unroll
      for (int ks = 0; ks < 2; ++ks) Pa[ks] = *(const bf16x8*)(Ps + r * 72 + ks * 32 + q * 8);
#pragma unroll
      for (int dt = 0; dt < 4; ++dt)
#pragma unroll
        for (int ks = 0; ks < 2; ++ks) {
          bf16x8 vb = *(const bf16x8*)(Vt + (dt * 16 + r) * 72 + ks * 32 + q * 8);
          O[dt] = __builtin_amdgcn_mfma_f32_16x16x32_bf16(Pa[ks], vb, O[dt], 0, 0, 0);
        }
    }
    __syncthreads();
  }
#pragma unroll
  for (int e = 0; e < 4; ++e) {
    float inv = 1.f / l_[e];
    int tok = base + q0 + wv * 16 + q * 4 + e;
#pragma unroll
    for (int dt = 0; dt < 4; ++dt)
      p.mixA[(size_t)tok * 384 + head * 64 + dt * 16 + r] = f2bf(O[dt][e] * inv);
  }
}

DI void rwkv_fix_phase(const P& p, int l, int bid, int nb) {
  const int tid = my_tid(), lane = tid & 63, wv = tid >> 6, r = lane & 15, q = lane >> 4;
  for (int item = bid; item < 32 * 32; item += nb) {
    const int ci = item >> 5, tile = item & 31;
    const int b = ci >> 3, h = (ci & 7) >> 1, d = ci & 1;
    const int base = NCTX + b * 4096, T = 4096;
    const int s0 = (T >> 1) + tile * 64 + wv * 16;
    bf16x8 af[2];
    {
      int sidx = s0 + r;
      int t = d ? (T - 1 - sidx) : sidx;
      const bf16_t* zp = p.proj + (size_t)(base + t) * PROJ_LD + RW0 + 768 + h * 64 + q * 8;
      af[0] = __builtin_bit_cast(bf16x8, *(const uint4*)(zp));
      af[1] = __builtin_bit_cast(bf16x8, *(const uint4*)(zp + 32));
    }
    f32x4 acc[4];
#pragma unroll
    for (int vt = 0; vt < 4; ++vt) {
      acc[vt] = (f32x4){0.f, 0.f, 0.f, 0.f};
#pragma unroll
      for (int ks = 0; ks < 2; ++ks) {
        const float* sp = p.smid + ((size_t)ci * 64 + vt * 16 + r) * 64 + ks * 32 + q * 8;
        float4 x0 = *(const float4*)(sp), x1 = *(const float4*)(sp + 4);
        bf16x8 bb;
        bb[0] = (short)f2bf(x0.x); bb[1] = (short)f2bf(x0.y); bb[2] = (short)f2bf(x0.z); bb[3] = (short)f2bf(x0.w);
        bb[4] = (short)f2bf(x1.x); bb[5] = (short)f2bf(x1.y); bb[6] = (short)f2bf(x1.z); bb[7] = (short)f2bf(x1.w);
        acc[vt] = __builtin_amdgcn_mfma_f32_16x16x32_bf16(af[ks], bb, acc[vt], 0, 0, 0);
      }
    }
#pragma unroll
    for (int e = 0; e < 4; ++e) {
      int sidx = s0 + q * 4 + e;
      int t = d ? (T - 1 - sidx) : sidx;
      bf16_t* op = p.outs + (size_t)(base + t) * OUTS_LD + d * 256 + h * 64 + r;
#pragma unroll
      for (int vt = 0; vt < 4; ++vt) op[vt * 16] = f2bf(bf2f(op[vt * 16]) + acc[vt][e]);
    }
  }
}

DI void mixers_phase(const P& p, int l, char* smem, int cidx) {
  __shared__ int s_item;
  const int n_rl = 384, n_sl = 48, n_rc = 512, n_sc = 192, n_al = 1536, n_ac = 384;
  const int n_mix = n_rl + n_sl + n_rc + n_sc + n_al + n_ac;
  const int total = n_mix + 2368;
  for (;;) {
    if (my_tid() == 0) s_item = (int)atomicAdd(&p.counters[cidx], 1u);
    __syncthreads();
    int it = s_item;
    __syncthreads();
    if (it >= total) { __builtin_amdgcn_s_setprio(0); break; }
    int kind, idx, rci = 0, rrg = 0, runit = 3;
    if (it < n_rl) { kind = 0; idx = it; runit = it >> 7; rci = (it & 127) >> 2; rrg = it & 3; }
    else if (it < n_rl + n_sl) { kind = 1; idx = it - n_rl; }
    else if (it < n_rl + n_sl + n_rc) { kind = 0; idx = it - n_rl - n_sl; rci = 32 + (idx >> 2); rrg = idx & 3; runit = 3; }
    else if (it < n_rl + n_sl + n_rc + n_sc) { kind = 1; idx = 48 + (it - n_rl - n_sl - n_rc); }
    else if (it < n_mix) { kind = 2; idx = it - (n_rl + n_sl + n_rc + n_sc); }
    else { kind = 3; idx = it - n_mix; }
    if (it < n_rl) __builtin_amdgcn_s_setprio(3); else if (it < n_rl + n_sl) __builtin_amdgcn_s_setprio(2); else __builtin_amdgcn_s_setprio(0);
    if (kind == 0) rwkv_item(p, l, rci, rrg, runit, smem);
    else if (kind == 1) ssd_item(p, l, idx, smem);
    else if (kind == 2) { attn_item(p, l, idx, smem); __syncthreads(); }
    else conv_rest_item(p, l, idx, (float*)smem);
  }
}

DI void unpack8(uint4 u, float (&f)[8]) {
  f[0] = __uint_as_float(u.x << 16); f[1] = __uint_as_float(u.x & 0xffff0000u);
  f[2] = __uint_as_float(u.y << 16); f[3] = __uint_as_float(u.y & 0xffff0000u);
  f[4] = __uint_as_float(u.z << 16); f[5] = __uint_as_float(u.z & 0xffff0000u);
  f[6] = __uint_as_float(u.w << 16); f[7] = __uint_as_float(u.w & 0xffff0000u);
}
DI float red8c(float x) { x += dpp_f<0xB1>(x); x += dpp_f<0x4E>(x); x += dpp_f<0x141>(x); return x; }
DI void ld8(const float* q, float (&f)[8]) { float4 a = *(const float4*)q, b = *(const float4*)(q + 4); f[0] = a.x; f[1] = a.y; f[2] = a.z; f[3] = a.w; f[4] = b.x; f[5] = b.y; f[6] = b.z; f[7] = b.w; }
DI void combine_phase(const P& p, int l, int bid, int nb) {
  int wv = my_tid() >> 6, lane = my_tid() & 63;
  const bool sl = lane < 48, rl = lane < 32;
  const int cs = (sl ? lane : 0) * 8;
  const int cr = (rl ? lane : 0) * 8;
  float cw[5][8], cb[8], nw[8];
#pragma unroll
  for (int j = 0; j < 5; ++j) ld8(p.ssd_conv_w + (l * 5 + j) * 640 + cs, cw[j]);
  ld8(p.ssd_conv_b + l * 640 + cs, cb);
  ld8(p.ssd_norm_w + l * 384 + cs, nw);
  const float Dh = p.ssd_d[l * 6 + (cs >> 6)];
  float mur[8], muk[8], muv[8], ka[8], rk[8], gw[8], gb[8];
  ld8(p.rwkv_mu + l * 1024 + cr, mur); ld8(p.rwkv_mu + l * 1024 + 256 + cr, muk); ld8(p.rwkv_mu + l * 1024 + 512 + cr, muv);
  ld8(p.rwkv_k_a + l * 256 + cr, ka); ld8(p.rwkv_r_k + l * 256 + cr, rk); ld8(p.rwkv_gn_w + l * 256 + cr, gw); ld8(p.rwkv_gn_b + l * 256 + cr, gb);
  for (int tok = bid * 4 + wv; tok < NTOK; tok += nb * 4) {
    int base, t, T, cj; tok_info(tok, base, t, T, cj);
    const bf16_t* os = p.outs + (size_t)tok * OUTS_LD;
    const bf16_t* pj = p.proj + (size_t)tok * PROJ_LD;
    float ys[8]; float ssq = 0.f;
    {
      float acc[8];
#pragma unroll
      for (int e = 0; e < 8; ++e) acc[e] = cb[e];
#pragma unroll
      for (int j = 0; j < 5; ++j) {
        int tt = t + j - 2;
        bool ok = (tt >= 0) && (tt < T);
        float x[8];
        unpack8(*(const uint4*)(pj + (ok ? (j - 2) * PROJ_LD : 0) + 1024 + cs), x);
#pragma unroll
        for (int e = 0; e < 8; ++e) acc[e] += ok ? cw[j][e] * x[e] : 0.f;
      }
      float yf[8], yb[8], z[8];
      unpack8(*(const uint4*)(os + 512 + cs), yf); unpack8(*(const uint4*)(os + 896 + cs), yb); unpack8(*(const uint4*)(pj + 640 + cs), z);
#pragma unroll
      for (int e = 0; e < 8; ++e) {
        float y = (yf[e] + yb[e] + Dh * siluf_(acc[e])) * siluf_(z[e]);
        y = sl ? y : 0.f;
        ys[e] = y; ssq += y * y;
      }
    }
    asm volatile("" ::: "memory");
    float rw[8];
    {
      float of[8], ob[8], o[8];
      unpack8(*(const uint4*)(os + cr), of); unpack8(*(const uint4*)(os + 256 + cr), ob);
      float s1 = 0.f;
#pragma unroll
      for (int e = 0; e < 8; ++e) { o[e] = of[e] + ob[e]; s1 += o[e]; }
      float mu = red8c(s1) * (1.f / 64.f);
      float s2 = 0.f;
#pragma unroll
      for (int e = 0; e < 8; ++e) { o[e] -= mu; s2 += o[e] * o[e]; }
      float rstd = rsqrtf(red8c(s2) * (1.f / 64.f) + 64e-5f);
      const bf16_t* pr = pj + RW0 + cr;
      const int om = (t > 0) ? -PROJ_LD : 0, on = (t < T - 1) ? PROJ_LD : 0;
      const float fm = (t > 0) ? 0.5f : 0.f, fn = (t < T - 1) ? 0.5f : 0.f;
      float c_[8], m_[8], n_[8], rr[8], kx[8], vv[8];
      unpack8(*(const uint4*)(pr), c_); unpack8(*(const uint4*)(pr + om), m_); unpack8(*(const uint4*)(pr + on), n_);
#pragma unroll
      for (int e = 0; e < 8; ++e) rr[e] = c_[e] + mur[e] * (fm * m_[e] + fn * n_[e] - c_[e]);
      unpack8(*(const uint4*)(pr + 256), c_); unpack8(*(const uint4*)(pr + 256 + om), m_); unpack8(*(const uint4*)(pr + 256 + on), n_);
#pragma unroll
      for (int e = 0; e < 8; ++e) kx[e] = c_[e] + muk[e] * (fm * m_[e] + fn * n_[e] - c_[e]);
      unpack8(*(const uint4*)(pr + 512), c_); unpack8(*(const uint4*)(pr + 512 + om), m_); unpack8(*(const uint4*)(pr + 512 + on), n_);
#pragma unroll
      for (int e = 0; e < 8; ++e) vv[e] = c_[e] + muv[e] * (fm * m_[e] + fn * n_[e] - c_[e]);
      const bf16_t* lp = p.lr + (size_t)tok * LR_LD;
      float a0[8], a1[8], g[8];
      unpack8(*(const uint4*)(lp + 512 + cr), a0); unpack8(*(const uint4*)(lp + 768 + cr), a1); unpack8(*(const uint4*)(lp + 1024 + cr), g);
      float bs = 0.f;
#pragma unroll
      for (int e = 0; e < 8; ++e) {
        float kd = kx[e] * (1.f + (a0[e] - 1.f) * ka[e]) + kx[e] * (1.f + (a1[e] - 1.f) * ka[e]);
        bs += rr[e] * kd * rk[e];
      }
      float bsum = red8c(bs);
#pragma unroll
      for (int e = 0; e < 8; ++e) rw[e] = (o[e] * rstd * gw[e] + gb[e] + bsum * vv[e]) * g[e];
    }
    float rs = rsqrtf(wave_sum(ssq) * (1.f / 384.f) + 1e-5f);
    bf16_t* od = p.outs + (size_t)tok * OUTS_LD;
    if (sl) *(uint4*)(od + cs) = make_uint4(pack_bf2(ys[0] * rs * nw[0], ys[1] * rs * nw[1]), pack_bf2(ys[2] * rs * nw[2], ys[3] * rs * nw[3]),
                                            pack_bf2(ys[4] * rs * nw[4], ys[5] * rs * nw[5]), pack_bf2(ys[6] * rs * nw[6], ys[7] * rs * nw[7]));
    if (rl) *(uint4*)(od + 384 + cr) = make_uint4(pack_bf2(rw[0], rw[1]), pack_bf2(rw[2], rw[3]), pack_bf2(rw[4], rw[5]), pack_bf2(rw[6], rw[7]));
  }
}

#define XB_TMO      128
#define XB_XCNT(j)  (256  + 64 * (j))
#define XB_XSUB(j)  (1280 + 64 * (j))
#define XB_XGEN(j)  (2304 + 64 * (j))
#define XB_TOP      3328
#define XB_TOPGEN   3392
#define XCD_BAR_WORDS 3456
#define XB_SPIN_CAP (1u << 22)
#define LAS __attribute__((address_space(3)))
DI unsigned xb_ld(unsigned* p)              { return __hip_atomic_load(p, __ATOMIC_RELAXED, __HIP_MEMORY_SCOPE_AGENT); }
DI unsigned xb_add(unsigned* p, unsigned v) { return __hip_atomic_fetch_add(p, v, __ATOMIC_RELAXED, __HIP_MEMORY_SCOPE_AGENT); }
DI unsigned xb_xcc_id() { return (unsigned)__builtin_amdgcn_s_getreg((3 << 11) | 20) & 0xFu; }
#define XB_SPIN(cond, bar) do { unsigned _sp = 0; while (cond) { __builtin_amdgcn_s_sleep(1); \
    if ((++_sp & 255u) == 0u) { if (xb_ld(&(bar)[XB_TMO])) break; if (_sp > XB_SPIN_CAP) { atomicAdd(&(bar)[XB_TMO], 1u); break; } } } } while (0)
struct XcdBarrier { unsigned* bar; unsigned x; volatile LAS unsigned* st; };
DI XcdBarrier xcd_barrier_post(unsigned* bar, volatile LAS unsigned* st) {
  XcdBarrier b; b.bar = bar; b.x = xb_xcc_id(); b.st = st;
  if (threadIdx.x == 0) (void)xb_add(&bar[XB_XCNT(b.x)], 1u);
  return b;
}
DI void xcd_barrier_complete(unsigned* bar, unsigned x, unsigned& nloc, unsigned& nx) {
  const unsigned G = gridDim.x * gridDim.y * gridDim.z;
  unsigned sum, cnt, mine, sp = 0u;
  for (;;) {
    sum = 0u; cnt = 0u; mine = 0u;
#pragma unroll
    for (unsigned j = 0; j < 16; ++j) { const unsigned c = xb_ld(&bar[XB_XCNT(j)]); sum += c; cnt += (c > 0u) ? 1u : 0u; mine = (j == x) ? c : mine; }
    if (sum == G) break;
    __builtin_amdgcn_s_sleep(1);
    if ((++sp & 255u) == 0u) { if (xb_ld(&bar[XB_TMO])) break; if (sp > XB_SPIN_CAP) { atomicAdd(&bar[XB_TMO], 1u); break; } }
  }
  nloc = mine > 0u ? mine : 1u; nx = cnt > 0u ? cnt : 1u;
}
DI void xcd_barrier(const XcdBarrier& b) {
  asm volatile("s_waitcnt vmcnt(0)" ::: "memory");
  __syncthreads();
  if (threadIdx.x == 0) {
    unsigned* bar = b.bar;
    __builtin_amdgcn_s_waitcnt(0);
    unsigned nloc = b.st[0], nx = b.st[1];
    if (nloc == 0u) { xcd_barrier_complete(bar, b.x, nloc, nx); b.st[0] = nloc; b.st[1] = nx; }
    const unsigned old = xb_add(&bar[XB_XSUB(b.x)], 1u);
    const unsigned gen = old / nloc;
    if (old + 1u == (gen + 1u) * nloc) {
      __builtin_amdgcn_fence(__ATOMIC_RELEASE, "agent");
      asm volatile("s_waitcnt vmcnt(0)" ::: "memory");
      const unsigned og = xb_add(&bar[XB_TOP], 1u);
      const unsigned tg = og / nx;
      if (og + 1u == (tg + 1u) * nx) xb_add(&bar[XB_TOPGEN], 1u);
      else XB_SPIN(xb_ld(&bar[XB_TOPGEN]) == tg, bar);
      __builtin_amdgcn_fence(__ATOMIC_ACQUIRE, "agent");
      xb_add(&bar[XB_XGEN(b.x)], 1u);
      asm volatile("s_waitcnt vmcnt(0)" ::: "memory");
    } else {
      XB_SPIN(xb_ld(&bar[XB_XGEN(b.x)]) == gen, bar);
      __builtin_amdgcn_fence(__ATOMIC_ACQUIRE, "agent");
      asm volatile("s_waitcnt vmcnt(0)" ::: "memory");
    }
  }
  __syncthreads();
}

constexpr int NPHASE = 24;
DI void run_phase(const P& p, int ph, int bid, int nb, char* smem) {
  if (ph == 0) { phase0(p, bid, nb, (float*)smem); return; }
  if (ph == 23) { lnmod_phase(p, 2, 1, 0, -1, bid, nb); return; }
  int l = (ph - 1) / 11, s = (ph - 1) % 11;
  switch (s) {
    case 0:
      if (l == 0) lnmod_phase(p, 0, 0, 0, 0, bid, nb);
      else lnmod_phase(p, 2, 0, 1, 0, bid, nb);
      break;
    case 1: gemm_phase_dma256(p.hA, 1024, p.Win + (size_t)l * 2816 * 1024, 80, 22, 1024, Epi1{p, l}, bid, nb, smem); break;
    case 2: prepA_phase(p, l, bid, nb); break;
    case 3: gemm_phase_dma(p.Alr, 256, p.Alr, 256, 1 << 30, p.Wlr + (size_t)l * 1280 * 256, 160, 10, 256, EpiLR{p, l}, bid, nb, smem); break;
    case 4: mixers_phase(p, l, smem, l); break;
    case 5: rwkv_fix_phase(p, l, bid, nb); break;
    case 6: combine_phase(p, l, bid, nb); break;
    case 7: gemm_phase_dma(p.mixA, 384, p.outs, OUTS_LD, 384, p.Wout, 160, 8, 1024, EpiRes{p, l, 2048}, bid, nb, smem); break;
    case 8: lnmod_phase(p, 1, l, l, 3072, bid, nb); break;
    case 9: gemm_phase_dma256(p.hA, 1024, p.Wffi, 80, 44, 1024, EpiFfn{p}, bid, nb, smem); break;
    case 10: gemm_phase_dma(p.hidden, HID_LD, p.hidden, HID_LD, 1 << 30, p.Wffo, 160, 8, 2816, EpiRes{p, l, 5120}, bid, nb, smem); break;
  }
}

#if !MEGA
__global__ void __launch_bounds__(256, 2) k_phase(P p, int ph) {
  __shared__ __attribute__((aligned(16))) char smem[SMEM_BYTES];
  run_phase(p, ph, blockIdx.x, gridDim.x, smem);
}
#endif

#if MEGA
__global__ void __launch_bounds__(256, 2) k_mega(P p) {
  __shared__ __attribute__((aligned(16))) char smem[SMEM_BYTES];
  cg::grid_group grid = cg::this_grid();
  __shared__ uint4 xb_words;
  if (threadIdx.x == 0) xb_words = make_uint4(0u, 0u, 0u, 0u);
  __syncthreads();
  XcdBarrier xb = xcd_barrier_post(p.bar, (volatile LAS unsigned*)&xb_words);
#define RUNPH(PH) { int bidv = blockIdx.x, nbv = gridDim.x; asm volatile("" : "+s"(bidv), "+s"(nbv) :: "memory"); run_phase(p, PH, bidv, nbv, smem); }
  RUNPH(0); xcd_barrier(xb); if (p.out == nullptr) grid.sync();
  RUNPH(1); xcd_barrier(xb); RUNPH(2); xcd_barrier(xb); RUNPH(3); xcd_barrier(xb); RUNPH(4); xcd_barrier(xb); RUNPH(5); xcd_barrier(xb);
  RUNPH(6); xcd_barrier(xb); RUNPH(7); xcd_barrier(xb); RUNPH(8); xcd_barrier(xb); RUNPH(9); xcd_barrier(xb); RUNPH(10); xcd_barrier(xb);
  RUNPH(11); xcd_barrier(xb);
  RUNPH(12); xcd_barrier(xb); RUNPH(13); xcd_barrier(xb); RUNPH(14); xcd_barrier(xb); RUNPH(15); xcd_barrier(xb); RUNPH(16); xcd_barrier(xb);
  RUNPH(17); xcd_barrier(xb); RUNPH(18); xcd_barrier(xb); RUNPH(19); xcd_barrier(xb); RUNPH(20); xcd_barrier(xb); RUNPH(21); xcd_barrier(xb);
  RUNPH(22); xcd_barrier(xb);
  RUNPH(23);
}
#endif

extern "C" void kernel_launch(void* const* d_in, const int* in_sizes, int n_in, void* d_out, int out_size, void* d_ws, size_t ws_size,
                              hipStream_t stream) {
  P p{};
  const float** fp = (const float**)&p;
  for (int i = 0; i < 36; ++i) fp[i] = (const float*)d_in[i];
  p.out = (float*)d_out;
  char* ws = (char*)d_ws;
  size_t off = 0;
  auto take = [&](size_t bytes) { char* r = ws + off; off += (bytes + 255) & ~(size_t)255; return r; };
  p.mod = (float*)take(2 * 5 * 6144 * 4);
  p.rope = (float*)take(64 * 16 * 2 * 4);
  p.bar = (unsigned*)take(16384);
  p.counters = p.bar + XCD_BAR_WORDS;
  p.smid = (float*)take((size_t)32 * 4096 * 4);
  p.Wlr = (bf16_t*)take((size_t)2 * 1280 * 256 * 2);
  p.Win = (bf16_t*)take((size_t)2 * 2816 * 1024 * 2);
  p.Wout = (bf16_t*)take((size_t)1024 * 1024 * 2);
  p.Wffi = (bf16_t*)take((size_t)5632 * 1024 * 2);
  p.Wffo = (bf16_t*)take((size_t)1024 * 2816 * 2);
  p.proj = (bf16_t*)take((size_t)NTOK * PROJ_LD * 2);
  p.hidden = p.proj;
  p.lr = (bf16_t*)take((size_t)NTOK * LR_LD * 2);
  p.mixA = (bf16_t*)take((size_t)NTOK * 384 * 2);
  p.outs = (bf16_t*)take((size_t)NTOK * OUTS_LD * 2);
  p.Alr = p.outs;
  p.hA = p.outs;
  if (off > ws_size) { fprintf(stderr, "workspace too small: need %zu have %zu\n", off, ws_size); }
#if MEGA
  hipMemsetAsync(d_ws, 0, (size_t)((char*)p.bar - (char*)d_ws) + 16384, stream);
  static int grid_blocks = 0;
  if (!grid_blocks) {
    int dev = 0, cus = 0, per_cu = 0;
    hipGetDevice(&dev);
    hipDeviceGetAttribute(&cus, hipDeviceAttributeMultiprocessorCount, dev);
    hipOccupancyMaxActiveBlocksPerMultiprocessor(&per_cu, k_mega, 256, 0);
    if (per_cu > 2) per_cu = 2;
    grid_blocks = cus * per_cu;
  }
  void* args[] = {&p};
  hipError_t e = hipLaunchCooperativeKernel((void*)k_mega, dim3(grid_blocks), dim3(256), args, 0, stream);
  if (e != hipSuccess) fprintf(stderr, "cooperative launch failed: %s (grid %d)\n", hipGetErrorString(e), grid_blocks);
#else
  for (int ph = 0; ph < NPHASE; ++ph) k_phase<<<512, 256, 0, stream>>>(p, ph);
#endif
}
```

```cpp
#include <hip/hip_runtime.h>
#include <hip/hip_cooperative_groups.h>
#include <stdint.h>
#include <stdio.h>
namespace cg = cooperative_groups;

#ifndef MEGA
#define MEGA 1
#endif

#define DI __device__ __forceinline__
typedef __attribute__((ext_vector_type(8))) short bf16x8;
typedef __attribute__((ext_vector_type(4))) float f32x4;
typedef unsigned short bf16_t;

constexpr int NTOK = 20480, NCTX = 4096;
constexpr int PROJ_LD = 2704, LR_LD = 1280, OUTS_LD = 1280, HID_LD = 2816;
constexpr size_t OFF_K = 20971520, OFF_V = 22020096, OFF_SSD = 23068672, OFF_RWKV = 24641536;
constexpr int TS = 16;
constexpr int RW0 = 1680;
constexpr int SMEM_BYTES = 73728;

DI float bf2f(bf16_t h) { return __uint_as_float(((unsigned)h) << 16); }
DI bf16_t f2bf(float f) { unsigned u = __float_as_uint(f); u += 0x7fffu + ((u >> 16) & 1u); return (bf16_t)(u >> 16); }
DI float sigmoidf_(float x) { return 1.f / (1.f + __expf(-x)); }
DI float siluf_(float x) { return x / (1.f + __expf(-x)); }

template <int CTRL> DI float dpp_f(float x) {
  return __builtin_bit_cast(float, __builtin_amdgcn_update_dpp(0, __builtin_bit_cast(int, x), CTRL, 0xf, 0xf, false));
}
DI float row16_sum(float x) { x += dpp_f<0x128>(x); x += dpp_f<0x124>(x); x += dpp_f<0x122>(x); x += dpp_f<0x121>(x); return x; }
DI float row16_max(float x) { x = fmaxf(x, dpp_f<0x128>(x)); x = fmaxf(x, dpp_f<0x124>(x)); x = fmaxf(x, dpp_f<0x122>(x)); x = fmaxf(x, dpp_f<0x121>(x)); return x; }
DI float wave_sum(float x) { x = row16_sum(x); x += __shfl_xor(x, 16); x += __shfl_xor(x, 32); return x; }

DI int my_tid() { int t = threadIdx.x; asm volatile("" : "+v"(t)); return t; }

struct P {
  const float *x_prompt, *x_sample, *cache_k, *cache_v, *state_ssd, *state_rwkv, *c, *c_ctx;
  const float *w_mod, *b_mod, *w_in, *w_out, *attn_sink, *ssd_conv_w, *ssd_conv_b, *ssd_dt_bias, *ssd_a_log, *ssd_d, *ssd_norm_w;
  const float *rwkv_mu, *rwkv_w0, *rwkv_w_up, *rwkv_a0, *rwkv_a_up, *rwkv_g_up, *rwkv_k_k, *rwkv_k_a, *rwkv_r_k, *rwkv_gn_w, *rwkv_gn_b;
  const float *ln1_w, *ln1_b, *ln2_w, *ln2_b, *ffn_w_in, *ffn_w_out;
  float* out;
  float* mod;
  float* rope;
  unsigned* counters;
  unsigned* bar;
  float* smid;
  bf16_t *Wlr;
  bf16_t *Win;
  bf16_t *Wout;
  bf16_t *Wffi;
  bf16_t *Wffo;
  bf16_t *proj;
  bf16_t *hidden;
  bf16_t *lr;
  bf16_t *mixA;
  bf16_t *outs;
  bf16_t *Alr;
  bf16_t *hA;
};

DI void tok_info(int tok, int& base, int& t, int& T, int& cj) {
  if (tok < NCTX) { base = tok & ~255; t = tok & 255; T = 256; cj = 0; }
  else { int u = tok - NCTX; base = NCTX + (u & ~4095); t = u & 4095; T = 4096; cj = 1 + (u >> 12); }
}

DI void p0_mod(const P& p, int item, float* smem) {
  int kh = item & 1; item >>= 1;
  int l = item / 96, nbk = item % 96;
  int tid = my_tid(), lane = tid & 63, wv = tid >> 6;
  float* s_c = smem;
  for (int i = tid; i < 5 * 512; i += 256) {
    int j = i >> 9, k = kh * 512 + (i & 511);
    float v = (j == 0) ? p.c_ctx[k] : p.c[(j - 1) * 1024 + k];
    s_c[i] = siluf_(v);
  }
  __syncthreads();
  const float* W = p.w_mod + (size_t)l * 1024 * 6144 + (size_t)(kh * 512) * 6144 + nbk * 64 + lane;
  float a0 = 0, a1 = 0, a2 = 0, a3 = 0, a4 = 0;
  int k0 = wv * 128;
#pragma unroll 16
  for (int k = k0; k < k0 + 128; ++k) {
    float w = W[(size_t)k * 6144];
    a0 += s_c[k] * w; a1 += s_c[512 + k] * w; a2 += s_c[1024 + k] * w; a3 += s_c[1536 + k] * w; a4 += s_c[2048 + k] * w;
  }
  float* s_red = smem + 5 * 512;
  s_red[(wv * 5 + 0) * 64 + lane] = a0; s_red[(wv * 5 + 1) * 64 + lane] = a1; s_red[(wv * 5 + 2) * 64 + lane] = a2;
  s_red[(wv * 5 + 3) * 64 + lane] = a3; s_red[(wv * 5 + 4) * 64 + lane] = a4;
  __syncthreads();
  if (tid < 64) {
    float bm = kh ? 0.f : p.b_mod[l * 6144 + nbk * 64 + tid];
    for (int j = 0; j < 5; ++j) {
      float s = bm;
      for (int w = 0; w < 4; ++w) s += s_red[(w * 5 + j) * 64 + tid];
      atomicAdd(&p.mod[(size_t)(l * 5 + j) * 6144 + nbk * 64 + tid], s);
    }
  }
  __syncthreads();
}

DI void conv_tile(const float* __restrict__ src, int K, int N, bf16_t* __restrict__ dst, int kt, int nt, int mapmode, float* smem) {
  int tid = my_tid(), lane = tid & 63, wv = tid >> 6;
  int np = nt * 64 + lane;
  int ncol;
  if (mapmode == 0) ncol = (np < N) ? np : -1;
  else if (mapmode == 2) ncol = (np < 1676) ? np : ((np < 1680) ? -1 : ((np < 2704) ? np - 4 : -1));
  else { int blk = np >> 5, w = np & 31; ncol = (w < 16) ? (blk * 16 + w) : (2816 + blk * 16 + (w - 16)); }
  for (int i = wv; i < 64; i += 4) {
    float v = (ncol >= 0) ? src[(size_t)(kt * 64 + i) * N + ncol] : 0.f;
    smem[i * 65 + lane] = v;
  }
  __syncthreads();
  for (int i = wv; i < 64; i += 4) dst[(size_t)(nt * 64 + i) * K + kt * 64 + lane] = f2bf(smem[lane * 65 + i]);
  __syncthreads();
}

DI void conv_win_item(const P& p, int l, int it, float* smem) {
  conv_tile(p.w_in + (size_t)l * 1024 * 2700, 1024, 2700, p.Win + (size_t)l * 2816 * 1024, it % 16, it / 16, 2, smem);
}
DI void conv_rest_item(const P& p, int l, int it, float* smem) {
  if (it < 256) conv_tile(p.w_out + (size_t)l * 1024 * 1024, 1024, 1024, p.Wout, it % 16, it / 16, 0, smem);
  else if (it < 256 + 1408) { it -= 256; conv_tile(p.ffn_w_in + (size_t)l * 1024 * 5632, 1024, 5632, p.Wffi, it % 16, it / 16, 1, smem); }
  else { it -= 256 + 1408; conv_tile(p.ffn_w_out + (size_t)l * 2816 * 1024, 2816, 1024, p.Wffo, it % 44, it / 44, 0, smem); }
}
DI void wlr_item(const P& p, int it) {
  for (int e = it * 4096 + my_tid(); e < it * 4096 + 4096; e += 256) {
    int l = e / 327680, rem = e % 327680, n = rem >> 8, k = rem & 255;
    float v = 0.f;
    int c = n & 255;
    if (n < 512) { int d = n >> 8; if (k < 64) v = p.rwkv_w_up[((size_t)(l * 2 + d) * 64 + k) * 256 + c]; }
    else if (n < 1024) { int d = (n - 512) >> 8; if (k >= 64 && k < 128) v = p.rwkv_a_up[((size_t)(l * 2 + d) * 64 + (k - 64)) * 256 + c]; }
    else { if (k >= 128) v = p.rwkv_g_up[((size_t)l * 128 + (k - 128)) * 256 + c]; }
    p.Wlr[e] = f2bf(v);
  }
}
DI void phase0(const P& p, int bid, int nb, float* smem) {
  const int n_mod = 384, n_win = 1408, n_rest = 0, n_wlr = 160;
  const int total = n_mod + n_win + n_rest + n_wlr + 1;
  for (int it = bid; it < total; it += nb) {
    int i = it;
    if (i < n_mod) { p0_mod(p, i, smem); continue; } i -= n_mod;
    if (i < n_win) { conv_win_item(p, i / 704, i % 704, smem); continue; } i -= n_win;
    if (i < n_rest) { conv_rest_item(p, 0, i, smem); continue; } i -= n_rest;
    if (i < n_wlr) { wlr_item(p, i); continue; }
    for (int e = my_tid(); e < 1024; e += 256) {
      int pos = e >> 4, f = e & 15;
      float inv = 1.0f / powf(10000.0f, (float)(2 * f) / 32.0f);
      float ang = (float)pos * inv;
      p.rope[e * 2] = cosf(ang); p.rope[e * 2 + 1] = sinf(ang);
    }
  }
}

DI void lnmod_phase(const P& p, int ln_kind, int ln_l, int mod_l, int mod_off, int bid, int nb) {
  int wv = my_tid() >> 6, lane = my_tid() & 63;
  float4 lw[4], lb[4];
  if (ln_kind != 0) {
    const float* lwp = (ln_kind == 1 ? p.ln1_w : p.ln2_w) + ln_l * 1024;
    const float* lbp = (ln_kind == 1 ? p.ln1_b : p.ln2_b) + ln_l * 1024;
#pragma unroll
    for (int i = 0; i < 4; ++i) { lw[i] = ((const float4*)lwp)[lane + 64 * i]; lb[i] = ((const float4*)lbp)[lane + 64 * i]; }
  }
  auto srcp = [&](int tok) -> const float4* {
    return (const float4*)((ln_kind == 0) ? (tok < NCTX ? p.x_prompt + (size_t)tok * 1024 : p.x_sample + (size_t)(tok - NCTX) * 1024)
                                          : p.out + (size_t)tok * 1024);
  };
  const int stride = nb * 4;
  int tok = bid * 4 + wv;
  float4 vn[4];
  if (tok < NTOK) {
    const float4* sp = srcp(tok);
#pragma unroll
    for (int i = 0; i < 4; ++i) vn[i] = sp[lane + 64 * i];
  }
  for (; tok < NTOK; tok += stride) {
    float4 v[4];
#pragma unroll
    for (int i = 0; i < 4; ++i) v[i] = vn[i];
    if (tok + stride < NTOK) {
      const float4* sp = srcp(tok + stride);
#pragma unroll
      for (int i = 0; i < 4; ++i) vn[i] = sp[lane + 64 * i];
    }
    int base, t, T, cj; tok_info(tok, base, t, T, cj);
    float4 sh[4], sc[4];
    if (mod_off >= 0) {
      const float* md = p.mod + (size_t)(mod_l * 5 + cj) * 6144 + mod_off;
#pragma unroll
      for (int i = 0; i < 4; ++i) { sh[i] = ((const float4*)md)[lane + 64 * i]; sc[i] = ((const float4*)(md + 1024))[lane + 64 * i]; }
    }
    if (ln_kind != 0) {
      float s = 0;
#pragma unroll
      for (int i = 0; i < 4; ++i) s += v[i].x + v[i].y + v[i].z + v[i].w;
      float mu = wave_sum(s) * (1.f / 1024.f);
      float ss = 0;
#pragma unroll
      for (int i = 0; i < 4; ++i) { float a = v[i].x - mu, b = v[i].y - mu, c = v[i].z - mu, d = v[i].w - mu; ss += a * a + b * b + c * c + d * d; }
      float rs = rsqrtf(wave_sum(ss) * (1.f / 1024.f) + 1e-5f);
#pragma unroll
      for (int i = 0; i < 4; ++i) {
        v[i].x = (v[i].x - mu) * rs * lw[i].x + lb[i].x; v[i].y = (v[i].y - mu) * rs * lw[i].y + lb[i].y;
        v[i].z = (v[i].z - mu) * rs * lw[i].z + lb[i].z; v[i].w = (v[i].w - mu) * rs * lw[i].w + lb[i].w;
      }
    }
    float4* dst = (float4*)(p.out + (size_t)tok * 1024);
#pragma unroll
    for (int i = 0; i < 4; ++i) dst[lane + 64 * i] = v[i];
    if (mod_off >= 0) {
#pragma unroll
      for (int i = 0; i < 4; ++i) {
        ushort4 o;
        o.x = f2bf(v[i].x * (1.f + sc[i].x) + sh[i].x); o.y = f2bf(v[i].y * (1.f + sc[i].y) + sh[i].y);
        o.z = f2bf(v[i].z * (1.f + sc[i].z) + sh[i].z); o.w = f2bf(v[i].w * (1.f + sc[i].w) + sh[i].w);
        ((ushort4*)(p.hA + (size_t)tok * 1024))[lane + 64 * i] = o;
      }
    }
  }
}

template <class Epi>
DI void gemm_phase(const bf16_t* __restrict__ A0, int lda0, const bf16_t* __restrict__ A1, int lda1, int ksplit,
                   const bf16_t* __restrict__ B, int Mt, int Nt, int K, Epi epi, int bid, int nb, char* smem) {
  bf16_t* As = (bf16_t*)smem;
  bf16_t* Bs = As + 2 * 128 * 32;
  const int tid = my_tid(), lane = tid & 63, wv = tid >> 6, wm = wv >> 1, wn = wv & 1, r = lane & 15, q = lane >> 4;
  const int lrow = tid >> 2, lk = (tid & 3) * 8;
  const int lsw = (((tid & 3) ^ ((lrow >> 2) & 3)) * 8);
  const int fsw = ((q ^ ((r >> 2) & 3)) * 8);
  const int nk = K / 32;
  const int xcd = bid & 7, jb = bid >> 3, nbx = nb >> 3, mpx = Mt >> 3;
  const int ntx = mpx * Nt;
  for (int idx = jb; idx < ntx; idx += nbx) {
    const int g = idx / (4 * Nt), rem = idx - g * 4 * Nt;
    const int nt = rem >> 2, mt = xcd * mpx + g * 4 + (rem & 3);
    f32x4 acc[4][4];
#pragma unroll
    for (int i = 0; i < 4; ++i)
#pragma unroll
      for (int j = 0; j < 4; ++j) acc[i][j] = (f32x4){0.f, 0.f, 0.f, 0.f};
    uint4 a00, a01, b00, b01, a10, a11, b10, b11;
#define GLOAD(kt_, x0, x1, y0, y1) { int k0 = (kt_) * 32; const bf16_t* Ap = A0; int lda = lda0; int kk = k0; \
      if (k0 >= ksplit) { Ap = A1; lda = lda1; kk = k0 - ksplit; } \
      x0 = *(const uint4*)(Ap + (size_t)(mt * 128 + lrow) * lda + kk + lk); \
      x1 = *(const uint4*)(Ap + (size_t)(mt * 128 + lrow + 64) * lda + kk + lk); \
      y0 = *(const uint4*)(B + (size_t)(nt * 128 + lrow) * K + k0 + lk); \
      y1 = *(const uint4*)(B + (size_t)(nt * 128 + lrow + 64) * K + k0 + lk); }
#define LSTORE(buf_, x0, x1, y0, y1) { bf16_t* an = As + (buf_) * 128 * 32; bf16_t* bn = Bs + (buf_) * 128 * 32; \
      *(uint4*)(an + lrow * 32 + lsw) = x0; *(uint4*)(an + (lrow + 64) * 32 + lsw) = x1; \
      *(uint4*)(bn + lrow * 32 + lsw) = y0; *(uint4*)(bn + (lrow + 64) * 32 + lsw) = y1; }
    auto compute = [&](int buf) {
      const bf16_t* as = As + buf * 128 * 32;
      const bf16_t* bs = Bs + buf * 128 * 32;
      bf16x8 af[4], bfr[4];
#pragma unroll
      for (int i = 0; i < 4; ++i) af[i] = *(const bf16x8*)(as + (wm * 64 + i * 16 + r) * 32 + fsw);
#pragma unroll
      for (int j = 0; j < 4; ++j) bfr[j] = *(const bf16x8*)(bs + (wn * 64 + j * 16 + r) * 32 + fsw);
#pragma unroll
      for (int i = 0; i < 4; ++i)
#pragma unroll
        for (int j = 0; j < 4; ++j) acc[i][j] = __builtin_amdgcn_mfma_f32_16x16x32_bf16(af[i], bfr[j], acc[i][j], 0, 0, 0);
    };
    GLOAD(0, a00, a01, b00, b01);
    GLOAD(1, a10, a11, b10, b11);
    LSTORE(0, a00, a01, b00, b01);
    __syncthreads();
    for (int kt = 0; kt < nk; kt += 2) {
      if (kt + 2 < nk) GLOAD(kt + 2, a00, a01, b00, b01);
      compute(0);
      LSTORE(1, a10, a11, b10, b11);
      __syncthreads();
      if (kt + 3 < nk) GLOAD(kt + 3, a10, a11, b10, b11);
      compute(1);
      if (kt + 2 < nk) LSTORE(0, a00, a01, b00, b01);
      __syncthreads();
    }
    epi(acc, mt * 128 + wm * 64, nt * 128 + wn * 64, r, q);
  }
}

#define RAW_BARRIER() do { asm volatile("s_waitcnt lgkmcnt(0)" ::: "memory"); __builtin_amdgcn_s_barrier(); asm volatile("" ::: "memory"); } while (0)
template <class Epi>
DI void gemm_phase_dma(const bf16_t* __restrict__ A0, int lda0, const bf16_t* __restrict__ A1, int lda1, int ksplit,
                       const bf16_t* __restrict__ B, int Mt, int Nt, int K, Epi epi, int bid, int nb, char* smem) {
  bf16_t* Ls = (bf16_t*)smem;
  const int tid = my_tid(), lane = tid & 63, wv = tid >> 6, wm = wv >> 1, wn = wv & 1, r = lane & 15, q = lane >> 4;
  const int fsw = ((q ^ ((r >> 2) & 3)) * 8);
  const int lr_ = lane >> 2, ls_ = lane & 3;
  const int csrc = (ls_ ^ ((lr_ >> 2) & 3)) * 8;
  const int nk = K / 32;
  const int xcd = bid & 7, jb = bid >> 3, nbx = nb >> 3, mpx = Mt >> 3;
  const int ntx = mpx * Nt;
  const int wrow = __builtin_amdgcn_readfirstlane(wv) * 32;
  for (int idx = jb; idx < ntx; idx += nbx) {
    const int g = idx / (4 * Nt), rem = idx - g * 4 * Nt;
    const int nt = rem >> 2, mt = xcd * mpx + g * 4 + (rem & 3);
    f32x4 acc[4][4];
#pragma unroll
    for (int i = 0; i < 4; ++i)
#pragma unroll
      for (int j = 0; j < 4; ++j) acc[i][j] = (f32x4){0.f, 0.f, 0.f, 0.f};
    const size_t arow = (size_t)(mt * 128 + wrow + lr_);
    const bf16_t* bsrc = B + (size_t)(nt * 128 + wrow + lr_) * K + csrc;
    auto glds = [&](int kt, int st) {
      const int k0 = kt * 32;
      const bf16_t* Ap = A0; int lda = lda0; int kk = k0;
      if (k0 >= ksplit) { Ap = A1; lda = lda1; kk = k0 - ksplit; }
      const bf16_t* asrc = Ap + arow * lda + kk + csrc;
      bf16_t* la = Ls + st * 8192 + wrow * 32;
      __builtin_amdgcn_global_load_lds((const unsigned*)asrc, (__attribute__((address_space(3))) unsigned*)la, 16, 0, 0);
      __builtin_amdgcn_global_load_lds((const unsigned*)(asrc + (size_t)16 * lda), (__attribute__((address_space(3))) unsigned*)(la + 16 * 32), 16, 0, 0);
      bf16_t* lb = la + 4096;
      __builtin_amdgcn_global_load_lds((const unsigned*)(bsrc + k0), (__attribute__((address_space(3))) unsigned*)lb, 16, 0, 0);
      __builtin_amdgcn_global_load_lds((const unsigned*)(bsrc + (size_t)16 * K + k0), (__attribute__((address_space(3))) unsigned*)(lb + 16 * 32), 16, 0, 0);
    };
    const unsigned aaddr0 = (unsigned)(size_t)smem + (unsigned)(((wm * 64 + r) * 32 + fsw) * 2);
    const unsigned baddr0 = (unsigned)(size_t)smem + 8192u + (unsigned)(((wn * 64 + r) * 32 + fsw) * 2);
    auto compute = [&](int st) {
      bf16x8 af0, af1, af2, af3, bf0, bf1, bf2, bf3;
      const unsigned aa = aaddr0 + (unsigned)st * 16384u, ba = baddr0 + (unsigned)st * 16384u;
      asm volatile("ds_read_b128 %0, %8\n\tds_read_b128 %1, %8 offset:1024\n\tds_read_b128 %2, %8 offset:2048\n\tds_read_b128 %3, %8 offset:3072\n\t"
                   "ds_read_b128 %4, %9\n\tds_read_b128 %5, %9 offset:1024\n\tds_read_b128 %6, %9 offset:2048\n\tds_read_b128 %7, %9 offset:3072\n\t"
                   "s_waitcnt lgkmcnt(0)"
                   : "=&v"(af0), "=&v"(af1), "=&v"(af2), "=&v"(af3), "=&v"(bf0), "=&v"(bf1), "=&v"(bf2), "=&v"(bf3)
                   : "v"(aa), "v"(ba) : "memory");
#define MF(i_, a_) acc[i_][0] = __builtin_amdgcn_mfma_f32_16x16x32_bf16(bf0, a_, acc[i_][0], 0, 0, 0); \
                   acc[i_][1] = __builtin_amdgcn_mfma_f32_16x16x32_bf16(bf1, a_, acc[i_][1], 0, 0, 0); \
                   acc[i_][2] = __builtin_amdgcn_mfma_f32_16x16x32_bf16(bf2, a_, acc[i_][2], 0, 0, 0); \
                   acc[i_][3] = __builtin_amdgcn_mfma_f32_16x16x32_bf16(bf3, a_, acc[i_][3], 0, 0, 0);
      MF(0, af0) MF(1, af1) MF(2, af2) MF(3, af3)
#undef MF
    };
    asm volatile("s_waitcnt vmcnt(0)" ::: "memory");
    glds(0, 0);
    glds(1, 1);
    int st = 0, st2 = 2;
    for (int kt = 0; kt < nk; ++kt) {
      if (kt + 1 < nk) asm volatile("s_waitcnt vmcnt(4)" ::: "memory");
      else asm volatile("s_waitcnt vmcnt(0)" ::: "memory");
      RAW_BARRIER();
      if (kt + 2 < nk) glds(kt + 2, st2);
      compute(st);
      st = (st == 2) ? 0 : st + 1;
      st2 = (st2 == 2) ? 0 : st2 + 1;
    }
    RAW_BARRIER();
    epi(acc, mt * 128 + wm * 64, nt * 128 + wn * 64, r, q);
  }
}

template <class Epi>
DI void gemm_phase_dma256(const bf16_t* __restrict__ A, int lda, const bf16_t* __restrict__ B, int Mt, int Nt, int K, Epi epi, int bid, int nb, char* smem) {
  bf16_t* Ls = (bf16_t*)smem;
  const int tid = my_tid(), lane = tid & 63, wv = tid >> 6, wm = wv >> 1, wn = wv & 1, r = lane & 15, q = lane >> 4;
  const int fsw = ((q ^ ((r >> 2) & 3)) * 8);
  const int lr_ = lane >> 2, ls_ = lane & 3;
  const int csrc = (ls_ ^ ((lr_ >> 2) & 3)) * 8;
  const int nk = K / 32;
  const int xcd = bid & 7, jb = bid >> 3, nbx = nb >> 3, mpx = Mt >> 3;
  const int ntx = mpx * Nt;
  const int wvu = __builtin_amdgcn_readfirstlane(wv);
  const unsigned aaddr0 = (unsigned)(size_t)smem + (unsigned)(((wm * 128 + r) * 32 + fsw) * 2);
  const unsigned baddr0 = (unsigned)(size_t)smem + 16384u + (unsigned)(((wn * 64 + r) * 32 + fsw) * 2);
  for (int idx = jb; idx < ntx; idx += nbx) {
    const int g = idx / (2 * Nt), rem = idx - g * 2 * Nt;
    const int nt = rem >> 1, mt = xcd * mpx + g * 2 + (rem & 1);
    f32x4 accA[4][4], accB[4][4];
#pragma unroll
    for (int i = 0; i < 4; ++i)
#pragma unroll
      for (int j = 0; j < 4; ++j) { accA[i][j] = (f32x4){0.f, 0.f, 0.f, 0.f}; accB[i][j] = (f32x4){0.f, 0.f, 0.f, 0.f}; }
    const bf16_t* asrc = A + (size_t)(mt * 256 + wvu * 64 + lr_) * lda + csrc;
    const bf16_t* bsrc = B + (size_t)(nt * 128 + wvu * 32 + lr_) * K + csrc;
    auto glds = [&](int kt, int st) {
      const int k0 = kt * 32;
      bf16_t* la = Ls + st * 12288 + wvu * 64 * 32;
#pragma unroll
      for (int u = 0; u < 4; ++u)
        __builtin_amdgcn_global_load_lds((const unsigned*)(asrc + (size_t)(u * 16) * lda + k0), (__attribute__((address_space(3))) unsigned*)(la + u * 16 * 32), 16, 0, 0);
      bf16_t* lb = Ls + st * 12288 + 8192 + wvu * 32 * 32;
#pragma unroll
      for (int u = 0; u < 2; ++u)
        __builtin_amdgcn_global_load_lds((const unsigned*)(bsrc + (size_t)(u * 16) * K + k0), (__attribute__((address_space(3))) unsigned*)(lb + u * 16 * 32), 16, 0, 0);
    };
    auto compute = [&](int st) {
      bf16x8 af0, af1, af2, af3, bf0, bf1, bf2, bf3;
      const unsigned aa = aaddr0 + (unsigned)st * 24576u, ba = baddr0 + (unsigned)st * 24576u;
      asm volatile("ds_read_b128 %0, %8\n\tds_read_b128 %1, %8 offset:1024\n\tds_read_b128 %2, %8 offset:2048\n\tds_read_b128 %3, %8 offset:3072\n\t"
                   "ds_read_b128 %4, %9\n\tds_read_b128 %5, %9 offset:1024\n\tds_read_b128 %6, %9 offset:2048\n\tds_read_b128 %7, %9 offset:3072\n\t"
                   "s_waitcnt lgkmcnt(0)"
                   : "=&v"(af0), "=&v"(af1), "=&v"(af2), "=&v"(af3), "=&v"(bf0), "=&v"(bf1), "=&v"(bf2), "=&v"(bf3)
                   : "v"(aa), "v"(ba) : "memory");
#define MF(acc_, i_, a_) acc_[i_][0] = __builtin_amdgcn_mfma_f32_16x16x32_bf16(a_, bf0, acc_[i_][0], 0, 0, 0); \
                         acc_[i_][1] = __builtin_amdgcn_mfma_f32_16x16x32_bf16(a_, bf1, acc_[i_][1], 0, 0, 0); \
                         acc_[i_][2] = __builtin_amdgcn_mfma_f32_16x16x32_bf16(a_, bf2, acc_[i_][2], 0, 0, 0); \
                         acc_[i_][3] = __builtin_amdgcn_mfma_f32_16x16x32_bf16(a_, bf3, acc_[i_][3], 0, 0, 0);
      MF(accA, 0, af0) MF(accA, 1, af1) MF(accA, 2, af2) MF(accA, 3, af3)
      bf16x8 ag0, ag1, ag2, ag3;
      asm volatile("ds_read_b128 %0, %4 offset:4096\n\tds_read_b128 %1, %4 offset:5120\n\tds_read_b128 %2, %4 offset:6144\n\tds_read_b128 %3, %4 offset:7168\n\t"
                   "s_waitcnt lgkmcnt(0)"
                   : "=&v"(ag0), "=&v"(ag1), "=&v"(ag2), "=&v"(ag3) : "v"(aa) : "memory");
      MF(accB, 0, ag0) MF(accB, 1, ag1) MF(accB, 2, ag2) MF(accB, 3, ag3)
#undef MF
    };
    asm volatile("s_waitcnt vmcnt(0)" ::: "memory");
    glds(0, 0);
    glds(1, 1);
    int st = 0, st2 = 2;
    for (int kt = 0; kt < nk; ++kt) {
      if (kt + 1 < nk) asm volatile("s_waitcnt vmcnt(6)" ::: "memory");
      else asm volatile("s_waitcnt vmcnt(0)" ::: "memory");
      RAW_BARRIER();
      if (kt + 2 < nk) glds(kt + 2, st2);
      compute(st);
      __builtin_amdgcn_sched_barrier(0);
      st = (st == 2) ? 0 : st + 1;
      st2 = (st2 == 2) ? 0 : st2 + 1;
    }
    RAW_BARRIER();
    epi(accA, mt * 256 + wm * 128, nt * 128 + wn * 64, r, q);
    asm volatile("" ::: "memory");
    __builtin_amdgcn_sched_barrier(0);
    epi(accB, mt * 256 + wm * 128 + 64, nt * 128 + wn * 64, r, q);
  }
}

struct Epi1 {
  const P& p; int l;
  DI void operator()(f32x4 (&acc)[4][4], int m0, int n0, int r, int q) const {
#pragma unroll
    for (int i = 0; i < 4; ++i)
#pragma unroll
      for (int e = 0; e < 4; ++e) {
        int row = m0 + i * 16 + q * 4 + e;
        asm volatile("" : "+v"(row));
        bf16_t* pr = p.proj + (size_t)row * PROJ_LD + n0 + r;
#pragma unroll
        for (int j = 0; j < 4; ++j) if (n0 + j * 16 + r < PROJ_LD) pr[j * 16] = f2bf(acc[i][j][e]);
      }
    if (m0 < NCTX && n0 >= 384 && n0 < 640) {
      float* cb = p.out + ((n0 < 512) ? OFF_K : OFF_V) + ((n0 - 384) & 127) + r;
#pragma unroll
      for (int i = 0; i < 4; ++i)
#pragma unroll
        for (int e = 0; e < 4; ++e) {
          int row = m0 + i * 16 + q * 4 + e;
          asm volatile("" : "+v"(row));
          float* cr = cb + ((size_t)((row >> 8) * 2 + l) * 256 + (row & 255)) * 128;
#pragma unroll
          for (int j = 0; j < 4; ++j) cr[j * 16] = acc[i][j][e];
        }
    }
  }
};
struct EpiLR {
  const P& p; int l;
  DI void operator()(f32x4 (&acc)[4][4], int m0, int n0, int r, int q) const {
#pragma unroll
    for (int i = 0; i < 4; ++i)
#pragma unroll
      for (int j = 0; j < 4; ++j) {
        int col = n0 + j * 16 + r;
        float bias = 0.f; bool sg = false;
        if (col < 512) { bias = p.rwkv_w0[l * 512 + col]; sg = true; }
        else if (col < 1024) { bias = p.rwkv_a0[l * 512 + (col - 512)]; sg = true; }
#pragma unroll
        for (int e = 0; e < 4; ++e) {
          int row = m0 + i * 16 + q * 4 + e;
          float v = acc[i][j][e] + bias;
          if (sg) v = sigmoidf_(v);
          p.lr[(size_t)row * LR_LD + col] = f2bf(v);
        }
      }
  }
};
struct EpiLRT {
  const P& p; int l;
  DI void operator()(f32x4 (&acc)[4][4], int m0, int n0, int r, int q) const {
#pragma unroll
    for (int j = 0; j < 4; ++j) {
      const int col = n0 + j * 16 + q * 4;
      float4 bias = make_float4(0.f, 0.f, 0.f, 0.f); bool sg = false;
      if (col < 512) { bias = *(const float4*)(p.rwkv_w0 + l * 512 + col); sg = true; }
      else if (col < 1024) { bias = *(const float4*)(p.rwkv_a0 + l * 512 + (col - 512)); sg = true; }
#pragma unroll
      for (int i = 0; i < 4; ++i) {
        int row = m0 + i * 16 + r;
        asm volatile("" : "+v"(row));
        float v0 = acc[i][j][0] + bias.x, v1 = acc[i][j][1] + bias.y, v2 = acc[i][j][2] + bias.z, v3 = acc[i][j][3] + bias.w;
        if (sg) { v0 = sigmoidf_(v0); v1 = sigmoidf_(v1); v2 = sigmoidf_(v2); v3 = sigmoidf_(v3); }
        *(uint2*)(p.lr + (size_t)row * LR_LD + col) = make_uint2((unsigned)f2bf(v0) | ((unsigned)f2bf(v1) << 16), (unsigned)f2bf(v2) | ((unsigned)f2bf(v3) << 16));
      }
    }
  }
};
struct EpiResT {
  const P& p; int l; int gate_off;
  DI void operator()(f32x4 (&acc)[4][4], int m0, int n0, int r, int q) const {
    int base, t, T, cj; tok_info(m0, base, t, T, cj);
    const float* g = p.mod + (size_t)(l * 5 + cj) * 6144 + gate_off + n0 + q * 4;
    float4 gv[4];
#pragma unroll
    for (int j = 0; j < 4; ++j) gv[j] = *(const float4*)(g + j * 16);
#pragma unroll
    for (int i = 0; i < 4; ++i) {
      int row = m0 + i * 16 + r;
      asm volatile("" : "+v"(row));
      float* xr = p.out + (size_t)row * 1024 + n0 + q * 4;
#pragma unroll
      for (int j = 0; j < 4; ++j) {
        float4 x = *(const float4*)(xr + j * 16);
        x.x = 1.41421356237f * x.x + gv[j].x * acc[i][j][0]; x.y = 1.41421356237f * x.y + gv[j].y * acc[i][j][1];
        x.z = 1.41421356237f * x.z + gv[j].z * acc[i][j][2]; x.w = 1.41421356237f * x.w + gv[j].w * acc[i][j][3];
        *(float4*)(xr + j * 16) = x;
      }
    }
  }
};
struct EpiRes {
  const P& p; int l; int gate_off;
  DI void operator()(f32x4 (&acc)[4][4], int m0, int n0, int r, int q) const {
    int base, t, T, cj; tok_info(m0, base, t, T, cj);
    const float* g = p.mod + (size_t)(l * 5 + cj) * 6144 + gate_off;
#pragma unroll
    for (int i = 0; i < 4; ++i)
#pragma unroll
      for (int j = 0; j < 4; ++j) {
        int col = n0 + j * 16 + r;
        float gv = g[col];
#pragma unroll
        for (int e = 0; e < 4; ++e) {
          int row = m0 + i * 16 + q * 4 + e;
          float* xp = p.out + (size_t)row * 1024 + col;
          *xp = 1.41421356237f * (*xp) + gv * acc[i][j][e];
        }
      }
  }
};
struct EpiFfn {
  const P& p;
  DI void operator()(f32x4 (&acc)[4][4], int m0, int n0, int r, int q) const {
#pragma unroll
    for (int i = 0; i < 4; ++i)
#pragma unroll
      for (int jp = 0; jp < 4; jp += 2) {
        int hc = ((n0 + jp * 16) >> 1) + r;
#pragma unroll
        for (int e = 0; e < 4; ++e) {
          int row = m0 + i * 16 + q * 4 + e;
          asm volatile("" : "+v"(row));
          float g = acc[i][jp][e], u = acc[i][jp + 1][e];
          p.hidden[(size_t)row * HID_LD + hc] = f2bf(siluf_(g) * u);
        }
      }
  }
};

DI float rw_mixed(const P& p, int l, int tok, int t, int T, int col) {
  const bf16_t* pr = p.proj + (size_t)tok * PROJ_LD + RW0 + col;
  float pc = bf2f(pr[0]);
  float pm = bf2f(pr[(t > 0) ? -PROJ_LD : 0]);
  float pn = bf2f(pr[(t < T - 1) ? PROJ_LD : 0]);
  pm = (t > 0) ? pm : 0.f; pn = (t < T - 1) ? pn : 0.f;
  float mu = p.rwkv_mu[l * 1024 + col];
  return pc + mu * (0.5f * (pm + pn) - pc);
}
DI float ssd_conv(const P& p, int l, int base, int t, int T, int ch) {
  float acc = p.ssd_conv_b[l * 640 + ch];
  float xv[5], wv_[5];
#pragma unroll
  for (int j = 0; j < 5; ++j) {
    int tt = t + j - 2;
    int tc = tt < 0 ? 0 : (tt > T - 1 ? T - 1 : tt);
    xv[j] = bf2f(p.proj[(size_t)(base + tc) * PROJ_LD + 1024 + ch]);
    wv_[j] = p.ssd_conv_w[(l * 5 + j) * 640 + ch];
  }
#pragma unroll
  for (int j = 0; j < 5; ++j) { int tt = t + j - 2; acc += (tt >= 0 && tt < T) ? wv_[j] * xv[j] : 0.f; }
  return siluf_(acc);
}

DI void prepA_phase(const P& p, int l, int bid, int nb) {
  const int tid = my_tid(), tq = tid >> 5, cg = (tid & 31) * 8;
  float mu[8];
  { float4 a = *(const float4*)(p.rwkv_mu + l * 1024 + 768 + cg), b = *(const float4*)(p.rwkv_mu + l * 1024 + 768 + cg + 4);
    mu[0] = a.x; mu[1] = a.y; mu[2] = a.z; mu[3] = a.w; mu[4] = b.x; mu[5] = b.y; mu[6] = b.z; mu[7] = b.w; }
  for (int tok = bid * 8 + tq; tok < NTOK; tok += nb * 8) {
    int base, t, T, cj; tok_info(tok, base, t, T, cj);
    const bf16_t* pr = p.proj + (size_t)tok * PROJ_LD + RW0 + 768 + cg;
    const int om = (t > 0) ? -PROJ_LD : 0, on = (t < T - 1) ? PROJ_LD : 0;
    const float fm = (t > 0) ? 0.5f : 0.f, fn = (t < T - 1) ? 0.5f : 0.f;
    uint4 uc = *(const uint4*)(pr), um = *(const uint4*)(pr + om), un = *(const uint4*)(pr + on);
    const unsigned c32[4] = {uc.x, uc.y, uc.z, uc.w}, m32[4] = {um.x, um.y, um.z, um.w}, n32[4] = {un.x, un.y, un.z, un.w};
    unsigned o32[4];
#pragma unroll
    for (int w = 0; w < 4; ++w) {
      float c0 = __uint_as_float(c32[w] << 16), c1 = __uint_as_float(c32[w] & 0xffff0000u);
      float m0 = __uint_as_float(m32[w] << 16), m1 = __uint_as_float(m32[w] & 0xffff0000u);
      float n0 = __uint_as_float(n32[w] << 16), n1 = __uint_as_float(n32[w] & 0xffff0000u);
      float x0 = c0 + mu[2 * w] * (fm * m0 + fn * n0 - c0);
      float x1 = c1 + mu[2 * w + 1] * (fm * m1 + fn * n1 - c1);
      float y0, y1;
      if (cg < 64) { y0 = tanhf(x0); y1 = tanhf(x1); }
      else if (cg < 128) { y0 = x0; y1 = x1; }
      else { y0 = sigmoidf_(x0); y1 = sigmoidf_(x1); }
      o32[w] = (unsigned)f2bf(y0) | ((unsigned)f2bf(y1) << 16);
    }
    *(uint4*)(p.Alr + (size_t)tok * 256 + cg) = make_uint4(o32[0], o32[1], o32[2], o32[3]);
  }
}

DI void unpack4(uint2 u, float (&f)[4]) {
  f[0] = __uint_as_float(u.x << 16); f[1] = __uint_as_float(u.x & 0xffff0000u);
  f[2] = __uint_as_float(u.y << 16); f[3] = __uint_as_float(u.y & 0xffff0000u);
}
DI void rwkv_item(const P& p, int l, int ci, int rg, int unit, char* smemc) {
  const int tid = my_tid(), lane = tid & 63, wv = tid >> 6;
  int seq, h = (ci & 7) >> 1, d = ci & 1, base, T;
  bool latent = ci < 32;
  if (latent) { int b = ci >> 3; seq = b; base = NCTX + b * 4096; T = 4096; }
  else { int s = (ci - 32) >> 3; seq = s; base = s * 256; T = 256; }
  float* s_kk = (float*)smemc; float* s_w = s_kk + TS * 64; float* s_b = s_w + TS * 64; float* s_kd = s_b + TS * 64; float* s_r = s_kd + TS * 64;
  float* s_v = s_r + TS * 64; float* s_o = s_v + TS * 16;
  bf16_t* raw = (bf16_t*)(s_o + 2 * TS * 16);
  bf16_t* rawlr = raw + (TS + 2) * 192;
  const int rl = lane >> 4, kq = lane & 15;
  const int row = rg * 16 + wv * 4 + rl;
  const int sbeg = (unit == 1 || unit == 2) ? (T >> 1) : 0;
  const int send = (unit == 0) ? (T >> 1) : T;
  float4 S;
  if (unit == 0) S = *(const float4*)(p.state_rwkv + ((((size_t)(seq * 2 + l) * 2 + d) * 4 + h) * 64 + row) * 64 + kq * 4);
  else if (unit == 2) S = make_float4((kq * 4 + 0 == row) ? 1.f : 0.f, (kq * 4 + 1 == row) ? 1.f : 0.f, (kq * 4 + 2 == row) ? 1.f : 0.f, (kq * 4 + 3 == row) ? 1.f : 0.f);
  else S = make_float4(0.f, 0.f, 0.f, 0.f);
  const float vmask = (unit == 2) ? 0.f : 1.f;
  bf16_t* const obase = (unit == 2) ? (p.proj + RW0 + 768 + h * 64 + rg * 16) : (p.outs + d * 256 + h * 64 + rg * 16);
  const int old_ = (unit == 2) ? PROJ_LD : OUTS_LD;
  float mu_r[4], mu_k[4], mu_v[4], k_k[4], k_a[4];
#pragma unroll
  for (int e = 0; e < 4; ++e) {
    int c = h * 64 + kq * 4 + e;
    mu_r[e] = p.rwkv_mu[l * 1024 + c]; mu_k[e] = p.rwkv_mu[l * 1024 + 256 + c]; mu_v[e] = p.rwkv_mu[l * 1024 + 512 + c];
    k_k[e] = p.rwkv_k_k[l * 256 + c]; k_a[e] = p.rwkv_k_a[l * 256 + c];
  }
  constexpr int NRK = (TS + 2) * 24, NRT = NRK + TS * 16, NSL = (NRT + 255) / 256;
  uint4 rgA[NSL], rgB[NSL];
  auto load_rawA = [&](int c0) {
#pragma unroll
    for (int n = 0; n < NSL; ++n) {
      int s = tid + 256 * n;
      const uint4* src = nullptr;
      if (s < NRK) {
        int rw_ = s / 24, rem = s - rw_ * 24;
        int sidx = c0 - 1 + rw_;
        if (sidx >= 0 && sidx < T) {
          int t = d ? (T - 1 - sidx) : sidx;
          src = (const uint4*)(p.proj + (size_t)(base + t) * PROJ_LD + RW0 + (rem >> 3) * 256 + h * 64 + (rem & 7) * 8);
        }
      } else if (s < NRT) {
        int s2 = s - NRK;
        int i = s2 >> 4, rem = s2 & 15;
        int sidx = c0 + i;
        int t = d ? (T - 1 - sidx) : sidx;
        src = (const uint4*)(p.lr + (size_t)(base + t) * LR_LD + (rem >> 3) * 512 + d * 256 + h * 64 + (rem & 7) * 8);
      }
      rgA[n] = src ? *src : make_uint4(0u, 0u, 0u, 0u);
    }
  };
  auto load_rawB = [&](int c0) {
#pragma unroll
    for (int n = 0; n < NSL; ++n) {
      int s = tid + 256 * n;
      const uint4* src = nullptr;
      if (s < NRK) {
        int rw_ = s / 24, rem = s - rw_ * 24;
        int sidx = c0 - 1 + rw_;
        if (sidx >= 0 && sidx < T) {
          int t = d ? (T - 1 - sidx) : sidx;
          src = (const uint4*)(p.proj + (size_t)(base + t) * PROJ_LD + RW0 + (rem >> 3) * 256 + h * 64 + (rem & 7) * 8);
        }
      } else if (s < NRT) {
        int s2 = s - NRK;
        int i = s2 >> 4, rem = s2 & 15;
        int sidx = c0 + i;
        int t = d ? (T - 1 - sidx) : sidx;
        src = (const uint4*)(p.lr + (size_t)(base + t) * LR_LD + (rem >> 3) * 512 + d * 256 + h * 64 + (rem & 7) * 8);
      }
      rgB[n] = src ? *src : make_uint4(0u, 0u, 0u, 0u);
    }
  };
  asm volatile("" :: "v"(mu_r[0]), "v"(mu_r[1]), "v"(mu_r[2]), "v"(mu_r[3]), "v"(mu_k[0]), "v"(mu_k[1]), "v"(mu_k[2]), "v"(mu_k[3]),
               "v"(mu_v[0]), "v"(mu_v[1]), "v"(mu_v[2]), "v"(mu_v[3]), "v"(k_k[0]), "v"(k_k[1]), "v"(k_k[2]), "v"(k_k[3]),
               "v"(k_a[0]), "v"(k_a[1]), "v"(k_a[2]), "v"(k_a[3]), "v"(S.x), "v"(S.y), "v"(S.z), "v"(S.w));
  load_rawA(sbeg);
  load_rawB(sbeg + TS);
  auto rest = [&](int c0) {
    if (c0 > sbeg) {
      const float* so = s_o + (((c0 / TS) - 1) & 1) * TS * 16;
      int i = tid >> 4, rr = tid & 15;
      int sidx = c0 - TS + i;
      int t = d ? (T - 1 - sidx) : sidx;
      obase[(size_t)(base + t) * old_ + rr] = f2bf(so[tid]);
    }
#pragma unroll
    for (int pp = 0; pp < TS / 16; ++pp) {
      int i = pp * 16 + wv * 4 + rl;
      const bf16_t* rc = raw + (i + 1) * 192 + kq * 4;
      float rC[4], rM[4], rN[4], kC[4], kM[4], kN[4], vC[4], vM[4], vN[4], sw[4], aa[4];
      unpack4(*(const uint2*)(rc), rC); unpack4(*(const uint2*)(rc - 192), rM); unpack4(*(const uint2*)(rc + 192), rN);
      unpack4(*(const uint2*)(rc + 64), kC); unpack4(*(const uint2*)(rc + 64 - 192), kM); unpack4(*(const uint2*)(rc + 64 + 192), kN);
      unpack4(*(const uint2*)(rc + 128), vC); unpack4(*(const uint2*)(rc + 128 - 192), vM); unpack4(*(const uint2*)(rc + 128 + 192), vN);
      unpack4(*(const uint2*)(rawlr + i * 128 + kq * 4), sw); unpack4(*(const uint2*)(rawlr + i * 128 + 64 + kq * 4), aa);
      float rr[4], kx[4], vv[4], kkr[4], ww[4];
      float ssq = 0.f;
#pragma unroll
      for (int e = 0; e < 4; ++e) {
        rr[e] = rC[e] + mu_r[e] * (0.5f * (rM[e] + rN[e]) - rC[e]);
        kx[e] = kC[e] + mu_k[e] * (0.5f * (kM[e] + kN[e]) - kC[e]);
        vv[e] = vC[e] + mu_v[e] * (0.5f * (vM[e] + vN[e]) - vC[e]);
        ww[e] = __expf(-0.6065306597126334f * sw[e]);
        kkr[e] = kx[e] * k_k[e];
        ssq += kkr[e] * kkr[e];
      }
      ssq = row16_sum(ssq);
      float inv = rsqrtf(ssq + 1e-12f);
      float4 kk4, b4, kd4;
      kk4.x = kkr[0] * inv; kk4.y = kkr[1] * inv; kk4.z = kkr[2] * inv; kk4.w = kkr[3] * inv;
      b4.x = kk4.x * aa[0]; b4.y = kk4.y * aa[1]; b4.z = kk4.z * aa[2]; b4.w = kk4.w * aa[3];
      kd4.x = kx[0] * (1.f + (aa[0] - 1.f) * k_a[0]); kd4.y = kx[1] * (1.f + (aa[1] - 1.f) * k_a[1]);
      kd4.z = kx[2] * (1.f + (aa[2] - 1.f) * k_a[2]); kd4.w = kx[3] * (1.f + (aa[3] - 1.f) * k_a[3]);
      *(float4*)(s_kk + i * 64 + kq * 4) = kk4;
      *(float4*)(s_w + i * 64 + kq * 4) = make_float4(ww[0], ww[1], ww[2], ww[3]);
      *(float4*)(s_b + i * 64 + kq * 4) = b4;
      *(float4*)(s_kd + i * 64 + kq * 4) = kd4;
      *(float4*)(s_r + i * 64 + kq * 4) = make_float4(rr[0], rr[1], rr[2], rr[3]);
      if ((kq >> 2) == rg) *(float4*)(s_v + i * 16 + (kq & 3) * 4) = make_float4(vv[0] * vmask, vv[1] * vmask, vv[2] * vmask, vv[3] * vmask);
    }
    __syncthreads();
    {
      const float* vb_ = s_kk + kq * 4;
      const float* vv_ = s_v + wv * 4 + rl;
      float4 kk4 = *(const float4*)(vb_), w4 = *(const float4*)(vb_ + TS * 64), b4 = *(const float4*)(vb_ + 2 * TS * 64);
      float4 kd4 = *(const float4*)(vb_ + 3 * TS * 64), r4 = *(const float4*)(vb_ + 4 * TS * 64);
      float vr = vv_[0];
      float* so_w = s_o + ((c0 / TS) & 1) * TS * 16;
#pragma unroll 4
      for (int i = 0; i < TS; ++i) {
        int in_ = (i + 1 < TS) ? i + 1 : i;
        float4 kk4n = *(const float4*)(vb_ + in_ * 64), w4n = *(const float4*)(vb_ + TS * 64 + in_ * 64), b4n = *(const float4*)(vb_ + 2 * TS * 64 + in_ * 64);
        float4 kd4n = *(const float4*)(vb_ + 3 * TS * 64 + in_ * 64), r4n = *(const float4*)(vb_ + 4 * TS * 64 + in_ * 64);
        float vrn = vv_[in_ * 16];
        float vx = __builtin_fmaf(S.x, w4.x, vr * kd4.x), vy = __builtin_fmaf(S.y, w4.y, vr * kd4.y);
        float vz = __builtin_fmaf(S.z, w4.z, vr * kd4.z), vw = __builtin_fmaf(S.w, w4.w, vr * kd4.w);
        float sk = __builtin_fmaf(S.z, kk4.z, S.x * kk4.x) + __builtin_fmaf(S.w, kk4.w, S.y * kk4.y);
        sk = row16_sum(sk);
        S.x = __builtin_fmaf(-sk, b4.x, vx); S.y = __builtin_fmaf(-sk, b4.y, vy);
        S.z = __builtin_fmaf(-sk, b4.z, vz); S.w = __builtin_fmaf(-sk, b4.w, vw);
        float o = S.x * r4.x + S.y * r4.y + S.z * r4.z + S.w * r4.w;
        o = row16_sum(o);
        so_w[i * 16 + wv * 4 + rl] = o;
        kk4 = kk4n; w4 = w4n; b4 = b4n; kd4 = kd4n; r4 = r4n; vr = vrn;
      }
    }
  };
  for (int c0 = sbeg; c0 < send; c0 += 2 * TS) {
#pragma unroll
    for (int n = 0; n < NSL; ++n) { int s = tid + 256 * n; if (s < NRT) *(uint4*)(raw + s * 8) = rgA[n]; }
    __syncthreads();
    if (c0 + 2 * TS < send) load_rawA(c0 + 2 * TS);
    rest(c0);
#pragma unroll
    for (int n = 0; n < NSL; ++n) { int s = tid + 256 * n; if (s < NRT) *(uint4*)(raw + s * 8) = rgB[n]; }
    __syncthreads();
    if (c0 + 3 * TS < send) load_rawB(c0 + 3 * TS);
    rest(c0 + TS);
  }
  __syncthreads();
  {
    const float* so = s_o + (((send / TS) - 1) & 1) * TS * 16;
    int i = tid >> 4, rr = tid & 15;
    int sidx = send - TS + i;
    int t = d ? (T - 1 - sidx) : sidx;
    obase[(size_t)(base + t) * old_ + rr] = f2bf(so[tid]);
  }
  if (unit == 3) {
    *(float4*)(p.out + OFF_RWKV + ((((size_t)(seq * 2 + l) * 2 + d) * 4 + h) * 64 + row) * 64 + kq * 4) = S;
  } else if (unit == 0) {
    *(float4*)(p.smid + ((size_t)ci * 64 + row) * 64 + kq * 4) = S;
  }
  __syncthreads();
}

DI unsigned pack_bf2(float lo, float hi) { return (unsigned)f2bf(lo) | ((unsigned)f2bf(hi) << 16); }
DI unsigned u4c(const uint4& v, int c) { return c == 0 ? v.x : (c == 1 ? v.y : (c == 2 ? v.z : v.w)); }
DI void ssd_item(const P& p, int l, int item, char* smemc) {
  const int tid = my_tid(), lane = tid & 63, wv = tid >> 6, r = lane & 15, q = lane >> 4;
  const bool latent = item < 48;
  const int cc = latent ? item : item - 48;
  const int sq = cc / 12, h = (cc % 12) >> 1, d = cc & 1, g = h / 3;
  const int base = latent ? (NCTX + sq * 4096) : (sq * 256);
  const int T = latent ? 4096 : 256;
  bf16_t* Cm = (bf16_t*)smemc;
  bf16_t* Bm = Cm + 64 * 72;
  bf16_t* XT = Bm + 64 * 72;
  bf16_t* BT = XT + 64 * 72;
  bf16_t* Ss = BT + 64 * 72;
  float* s_cs = (float*)(Ss + 64 * 72);
  float* s_dt = s_cs + 64;
  float* s_sc = s_dt + 64;
  float* s_cw = s_sc + 64;
  const float dtb = p.ssd_dt_bias[(l * 2 + d) * 6 + h];
  const float Aneg = -__expf(p.ssd_a_log[(l * 2 + d) * 6 + h]);
  for (int idx = tid; idx < 6 * 192; idx += 256) {
    int j = idx / 192, cq = idx - j * 192;
    int ch = (cq < 64) ? (h * 64 + cq) : ((cq < 128) ? (384 + g * 64 + (cq - 64)) : (512 + g * 64 + (cq - 128)));
    int jj = (j < 5 && d) ? (4 - j) : j;
    s_cw[idx] = (j < 5) ? p.ssd_conv_w[(l * 5 + jj) * 640 + ch] : p.ssd_conv_b[l * 640 + ch];
  }
  f32x4 S[4];
  const size_t st_off = (((size_t)(sq * 2 + l) * 2 + d) * 6 + h) * 4096;
#pragma unroll
  for (int nt = 0; nt < 4; ++nt)
#pragma unroll
    for (int e = 0; e < 4; ++e) {
      float v = latent ? p.state_ssd[st_off + (size_t)(wv * 16 + q * 4 + e) * 64 + nt * 16 + r] : 0.f;
      S[nt][e] = v;
      Ss[(wv * 16 + q * 4 + e) * 72 + nt * 16 + r] = f2bf(v);
    }
  const int sg = tid / 24, cg = tid - sg * 24;
  const int gcol = (cg < 8) ? (1024 + h * 64 + cg * 8) : ((cg < 16) ? (1024 + 384 + g * 64 + (cg - 8) * 8) : (1024 + 512 + g * 64 + (cg - 16) * 8));
  uint4 raw[12]; float dtraw = 0.f;
  auto load_raw = [&](int c0) {
    if (tid < 192) {
#pragma unroll
      for (int k = 0; k < 12; ++k) {
        int sidx = c0 + sg * 8 - 2 + k;
        bool ok = (sidx >= 0) && (sidx < T);
        int sc_ = ok ? sidx : 0;
        int t = d ? (T - 1 - sc_) : sc_;
        uint4 v = *(const uint4*)(p.proj + (size_t)(base + t) * PROJ_LD + gcol);
        raw[k] = ok ? v : make_uint4(0u, 0u, 0u, 0u);
      }
    } else {
      int sidx = c0 + lane;
      int t = d ? (T - 1 - sidx) : sidx;
      dtraw = bf2f(p.proj[(size_t)(base + t) * PROJ_LD + 1664 + d * 6 + h]);
    }
  };
  load_raw(0);
  __syncthreads();
  for (int c0 = 0; c0 < T; c0 += 64) {
    if (tid < 192) {
#pragma unroll
      for (int pc = 0; pc < 4; ++pc) {
        float in0[12], in1[12];
#pragma unroll
        for (int k = 0; k < 12; ++k) { unsigned u = u4c(raw[k], pc); in0[k] = __uint_as_float(u << 16); in1[k] = __uint_as_float(u & 0xffff0000u); }
        const int cq = cg * 8 + pc * 2;
        float w0[6], w1[6];
#pragma unroll
        for (int j = 0; j < 6; ++j) { float2 w = *(const float2*)(s_cw + j * 192 + cq); w0[j] = w.x; w1[j] = w.y; }
        float o0[8], o1[8];
#pragma unroll
        for (int s_ = 0; s_ < 8; ++s_) {
          float a0 = w0[5], a1 = w1[5];
#pragma unroll
          for (int j = 0; j < 5; ++j) { a0 += w0[j] * in0[s_ + j]; a1 += w1[j] * in1[s_ + j]; }
          o0[s_] = siluf_(a0); o1[s_] = siluf_(a1);
        }
        if (cg >= 8) {
          bf16_t* dstR = ((cg < 16) ? (Bm + (cg - 8) * 8) : (Cm + (cg - 16) * 8)) + pc * 2;
#pragma unroll
          for (int s_ = 0; s_ < 8; ++s_) *(unsigned*)(dstR + (sg * 8 + s_) * 72) = pack_bf2(o0[s_], o1[s_]);
        }
        if (cg < 16) {
          uint4 t0 = make_uint4(pack_bf2(o0[0], o0[1]), pack_bf2(o0[2], o0[3]), pack_bf2(o0[4], o0[5]), pack_bf2(o0[6], o0[7]));
          uint4 t1 = make_uint4(pack_bf2(o1[0], o1[1]), pack_bf2(o1[2], o1[3]), pack_bf2(o1[4], o1[5]), pack_bf2(o1[6], o1[7]));
          bf16_t* dstT = (cg < 8) ? (XT + (cg * 8 + pc * 2) * 72) : (BT + ((cg - 8) * 8 + pc * 2) * 72);
          *(uint4*)(dstT + sg * 8) = t0;
          *(uint4*)(dstT + 72 + sg * 8) = t1;
        }
      }
    } else {
      float dtr = dtraw + dtb;
      float dt = (dtr > 20.f) ? dtr : log1pf(__expf(dtr));
      float cs = Aneg * dt;
#pragma unroll
      for (int o = 1; o < 64; o <<= 1) { float v = __shfl_up(cs, o); if (lane >= o) cs += v; }
      float cs63 = __shfl(cs, 63);
      s_cs[lane] = cs; s_dt[lane] = dt; s_sc[lane] = __expf(cs63 - cs) * dt;
    }
    __syncthreads();
    {
      const int i0 = wv * 16;
      bf16x8 cf[2];
#pragma unroll
      for (int ks = 0; ks < 2; ++ks) cf[ks] = *(const bf16x8*)(Cm + (i0 + r) * 72 + ks * 32 + q * 8);
      f32x4 G[4];
#pragma unroll
      for (int jt = 0; jt < 4; ++jt) {
        G[jt] = (f32x4){0.f, 0.f, 0.f, 0.f};
#pragma unroll
        for (int ks = 0; ks < 2; ++ks) {
          bf16x8 bb = *(const bf16x8*)(Bm + (jt * 16 + r) * 72 + ks * 32 + q * 8);
          G[jt] = __builtin_amdgcn_mfma_f32_16x16x32_bf16(cf[ks], bb, G[jt], 0, 0, 0);
        }
      }
      float csi[4];
#pragma unroll
      for (int e = 0; e < 4; ++e) csi[e] = s_cs[i0 + q * 4 + e];
#pragma unroll
      for (int jt = 0; jt < 4; ++jt) {
        const int j = jt * 16 + r;
        const float csj = s_cs[j], dtj = s_dt[j];
#pragma unroll
        for (int e = 0; e < 4; ++e) {
          const int i = i0 + q * 4 + e;
          float dec = (j <= i) ? __expf(csi[e] - csj) * dtj : 0.f;
          Cm[(i0 + q * 4 + e) * 72 + jt * 16 + r] = f2bf(G[jt][e] * dec);
        }
      }
      bf16x8 mf[2];
#pragma unroll
      for (int ks = 0; ks < 2; ++ks) mf[ks] = *(const bf16x8*)(Cm + (i0 + r) * 72 + ks * 32 + q * 8);
      f32x4 Y[4];
#pragma unroll
      for (int pt = 0; pt < 4; ++pt) {
        Y[pt] = (f32x4){0.f, 0.f, 0.f, 0.f};
#pragma unroll
        for (int ks = 0; ks < 2; ++ks) {
          bf16x8 sb = *(const bf16x8*)(Ss + (pt * 16 + r) * 72 + ks * 32 + q * 8);
          Y[pt] = __builtin_amdgcn_mfma_f32_16x16x32_bf16(cf[ks], sb, Y[pt], 0, 0, 0);
        }
#pragma unroll
        for (int e = 0; e < 4; ++e) Y[pt][e] *= __expf(csi[e]);
#pragma unroll
        for (int ks = 0; ks < 2; ++ks) {
          bf16x8 xb = *(const bf16x8*)(XT + (pt * 16 + r) * 72 + ks * 32 + q * 8);
          Y[pt] = __builtin_amdgcn_mfma_f32_16x16x32_bf16(mf[ks], xb, Y[pt], 0, 0, 0);
        }
      }
#pragma unroll
      for (int e = 0; e < 4; ++e) {
        int sidx = c0 + i0 + q * 4 + e;
        int t = d ? (T - 1 - sidx) : sidx;
        bf16_t* od = p.outs + (size_t)(base + t) * OUTS_LD + 512 + d * 384 + h * 64 + r;
#pragma unroll
        for (int pt = 0; pt < 4; ++pt) od[pt * 16] = f2bf(Y[pt][e]);
      }
      if (c0 + 64 < T) load_raw(c0 + 64);
      const float dall = __expf(s_cs[63]);
      bf16x8 xa[2];
#pragma unroll
      for (int ks = 0; ks < 2; ++ks) {
        bf16x8 xr = *(const bf16x8*)(XT + (i0 + r) * 72 + ks * 32 + q * 8);
        float4 sA = *(const float4*)(s_sc + ks * 32 + q * 8), sB = *(const float4*)(s_sc + ks * 32 + q * 8 + 4);
        float scl[8] = {sA.x, sA.y, sA.z, sA.w, sB.x, sB.y, sB.z, sB.w};
#pragma unroll
        for (int jj = 0; jj < 8; ++jj) xa[ks][jj] = (short)f2bf(bf2f((bf16_t)xr[jj]) * scl[jj]);
      }
#pragma unroll
      for (int nt = 0; nt < 4; ++nt) {
#pragma unroll
        for (int e = 0; e < 4; ++e) S[nt][e] *= dall;
#pragma unroll
        for (int ks = 0; ks < 2; ++ks) {
          bf16x8 bt = *(const bf16x8*)(BT + (nt * 16 + r) * 72 + ks * 32 + q * 8);
          S[nt] = __builtin_amdgcn_mfma_f32_16x16x32_bf16(xa[ks], bt, S[nt], 0, 0, 0);
        }
      }
    }
    __syncthreads();
#pragma unroll
    for (int nt = 0; nt < 4; ++nt)
#pragma unroll
      for (int e = 0; e < 4; ++e) Ss[(wv * 16 + q * 4 + e) * 72 + nt * 16 + r] = f2bf(S[nt][e]);
  }
  if (!latent) {
#pragma unroll
    for (int nt = 0; nt < 4; ++nt)
#pragma unroll
      for (int e = 0; e < 4; ++e) p.out[OFF_SSD + st_off + (size_t)(wv * 16 + q * 4 + e) * 64 + nt * 16 + r] = S[nt][e];
  }
  __syncthreads();
}

DI void attn_item(const P& p, int l, int item, char* smemc) {
  const int tid = my_tid(), lane = tid & 63, wv = tid >> 6, r = lane & 15, q = lane >> 4;
  bool latent = item < 1536;
  int b, qb, head, base, T;
  if (latent) { b = item / 384; int rem = item % 384; qb = rem / 6; head = rem % 6; base = NCTX + b * 4096; T = 4096; }
  else { int it = item - 1536; b = it / 24; int rem = it % 24; qb = rem / 6; head = rem % 6; base = b * 256; T = 256; }
  const int kvh = head / 3;
  const int q0 = qb * 64;
  bf16_t* Ks = (bf16_t*)smemc;
  bf16_t* Vt = Ks + 64 * 72;
  bf16_t* Ps = Vt + 64 * 72 + wv * 16 * 72;
  bf16x8 Qf[2];
  {
    int qpos = q0 + wv * 16 + r;
    int qtok = base + qpos;
#pragma unroll
    for (int ks = 0; ks < 2; ++ks) {
      const bf16_t* src = p.proj + (size_t)qtok * PROJ_LD + head * 64 + ks * 32;
      uint4 own = *(const uint4*)(src + q * 8);
      bf16x8 o8 = __builtin_bit_cast(bf16x8, own);
      bf16x8 f;
      if (latent) {
        uint4 par = *(const uint4*)(src + (q ^ 2) * 8);
        bf16x8 p8 = __builtin_bit_cast(bf16x8, par);
        int pos = ks ? (qpos & 63) : (qpos >> 6);
        const float* rt = p.rope + (pos * 16 + (q & 1) * 8) * 2;
        float sgn = (q < 2) ? -1.f : 1.f;
#pragma unroll
        for (int j = 0; j < 8; ++j) {
          float cs = rt[j * 2], sn = rt[j * 2 + 1];
          float v = bf2f((bf16_t)o8[j]) * cs + sgn * bf2f((bf16_t)p8[j]) * sn;
          f[j] = (short)f2bf(v * 0.125f);
        }
      } else {
#pragma unroll
        for (int j = 0; j < 8; ++j) f[j] = (short)f2bf(bf2f((bf16_t)o8[j]) * 0.125f);
      }
      Qf[ks] = f;
    }
  }
  float m_[4], l_[4];
  f32x4 O[4];
  {
    float sk = p.attn_sink[l * 6 + head];
#pragma unroll
    for (int e = 0; e < 4; ++e) { m_[e] = sk; l_[e] = 1.f; }
#pragma unroll
    for (int dt = 0; dt < 4; ++dt) O[dt] = (f32x4){0.f, 0.f, 0.f, 0.f};
  }
  const int nloc = latent ? 5 : 4;
  const int ntile = latent ? 9 : 4;
  for (int ti = 0; ti < ntile; ++ti) {
    bool local = ti < nloc;
    int ts = 0;
    if (local) { ts = latent ? (q0 - 128 + 64 * ti) : 64 * ti; if (ts < 0 || ts >= T) continue; }
    else ts = (ti - nloc) * 64;
    {
      int key = tid >> 2, ch = tid & 3;
      {
        float vf[16];
        if (local) {
          const bf16_t* vsrc = p.proj + (size_t)(base + ts + key) * PROJ_LD + 512 + kvh * 64 + ch * 16;
          bf16x8 v0 = __builtin_bit_cast(bf16x8, *(const uint4*)(vsrc)), v1 = __builtin_bit_cast(bf16x8, *(const uint4*)(vsrc + 8));
#pragma unroll
          for (int j = 0; j < 8; ++j) { vf[j] = bf2f((bf16_t)v0[j]); vf[8 + j] = bf2f((bf16_t)v1[j]); }
        } else {
          const float* vsrc = p.cache_v + ((size_t)((b * 2 + l) * 256 + ts + key)) * 128 + kvh * 64 + ch * 16;
#pragma unroll
          for (int j4 = 0; j4 < 4; ++j4) { float4 c4 = ((const float4*)vsrc)[j4]; vf[j4 * 4] = c4.x; vf[j4 * 4 + 1] = c4.y; vf[j4 * 4 + 2] = c4.z; vf[j4 * 4 + 3] = c4.w; }
        }
#pragma unroll
        for (int j = 0; j < 16; ++j) Vt[(ch * 16 + j) * 72 + key] = f2bf(vf[j]);
      }
      asm volatile("" ::: "memory");
#pragma unroll
      for (int hf = 0; hf < 2; ++hf) {
        float kf[8];
        if (local) {
          const bf16_t* ksrc = p.proj + (size_t)(base + ts + key) * PROJ_LD + 384 + kvh * 64;
          bf16x8 k0 = __builtin_bit_cast(bf16x8, *(const uint4*)(ksrc + ch * 16 + hf * 8));
#pragma unroll
          for (int j = 0; j < 8; ++j) kf[j] = bf2f((bf16_t)k0[j]);
          if (latent) {
            bf16x8 p0 = __builtin_bit_cast(bf16x8, *(const uint4*)(ksrc + (ch ^ 1) * 16 + hf * 8));
            int kpos = ts + key;
            int pos = (ch >> 1) ? (kpos & 63) : (kpos >> 6);
            const float4* rt = (const float4*)(p.rope + pos * 32 + hf * 16);
            float sgn = (ch & 1) ? 1.f : -1.f;
#pragma unroll
            for (int j2 = 0; j2 < 4; ++j2) {
              float4 cs = rt[j2];
              kf[2 * j2] = kf[2 * j2] * cs.x + sgn * bf2f((bf16_t)p0[2 * j2]) * cs.y;
              kf[2 * j2 + 1] = kf[2 * j2 + 1] * cs.z + sgn * bf2f((bf16_t)p0[2 * j2 + 1]) * cs.w;
            }
          }
        } else {
          const float* ksrc = p.cache_k + ((size_t)((b * 2 + l) * 256 + ts + key)) * 128 + kvh * 64 + ch * 16 + hf * 8;
#pragma unroll
          for (int j4 = 0; j4 < 2; ++j4) { float4 a = ((const float4*)ksrc)[j4]; kf[j4 * 4] = a.x; kf[j4 * 4 + 1] = a.y; kf[j4 * 4 + 2] = a.z; kf[j4 * 4 + 3] = a.w; }
        }
        bf16x8 k8a;
#pragma unroll
        for (int j = 0; j < 8; ++j) k8a[j] = (short)f2bf(kf[j]);
        *(bf16x8*)(Ks + key * 72 + ch * 16 + hf * 8) = k8a;
        asm volatile("" ::: "memory");
      }
    }
    __syncthreads();
    {
      f32x4 S[4];
#pragma unroll
      for (int jt = 0; jt < 4; ++jt) {
        S[jt] = (f32x4){0.f, 0.f, 0.f, 0.f};
#pragma unroll
        for (int ks = 0; ks < 2; ++ks) {
          bf16x8 kb = *(const bf16x8*)(Ks + (jt * 16 + r) * 72 + ks * 32 + q * 8);
          S[jt] = __builtin_amdgcn_mfma_f32_16x16x32_bf16(Qf[ks], kb, S[jt], 0, 0, 0);
        }
      }
      if (local && latent) {
#pragma unroll
        for (int jt = 0; jt < 4; ++jt) {
          int kp = ts + jt * 16 + r;
#pragma unroll
          for (int e = 0; e < 4; ++e) {
            int qp = q0 + wv * 16 + q * 4 + e;
            int df = qp - kp; df = df < 0 ? -df : df;
            if (df > 128) S[jt][e] = -1e30f;
          }
        }
      }
#pragma unroll
      for (int e = 0; e < 4; ++e) {
        float mx = fmaxf(fmaxf(S[0][e], S[1][e]), fmaxf(S[2][e], S[3][e]));
        mx = row16_max(mx);
        float mn = fmaxf(m_[e], mx);
        float alpha = __expf(m_[e] - mn);
        m_[e] = mn;
        float rs = 0.f;
#pragma unroll
        for (int jt = 0; jt < 4; ++jt) { float pv = __expf(S[jt][e] - mn); S[jt][e] = pv; rs += pv; }
        rs = row16_sum(rs);
        l_[e] = l_[e] * alpha + rs;
#pragma unroll
        for (int dt = 0; dt < 4; ++dt) O[dt][e] *= alpha;
      }
#pragma unroll
      for (int jt = 0; jt < 4; ++jt)
#pragma unroll
        for (int e = 0; e < 4; ++e) Ps[(q * 4 + e) * 72 + jt * 16 + r] = f2bf(S[jt][e]);
      bf16x8 Pa[2];
#pragma unroll
      for (int ks = 0; ks < 2; ++ks) Pa[ks] = *(const bf16x8*)(Ps + r * 72 + ks * 32 + q * 8);
#pragma unroll
      for (int dt = 0; dt < 4; ++dt)
#pragma unroll
        for (int ks = 0; ks < 2; ++ks) {
          bf16x8 vb = *(const bf16x8*)(Vt + (dt * 16 + r) * 72 + ks * 32 + q * 8);
          O[dt] = __builtin_amdgcn_mfma_f32_16x16x32_bf16(Pa[ks], vb, O[dt], 0, 0, 0);
        }
    }
    __syncthreads();
  }
#pragma unroll
  for (int e = 0; e < 4; ++e) {
    float inv = 1.f / l_[e];
    int tok = base + q0 + wv * 16 + q * 4 + e;
#pragma unroll
    for (int dt = 0; dt < 4; ++dt)
      p.mixA[(size_t)tok * 384 + head * 64 + dt * 16 + r] = f2bf(O[dt][e] * inv);
  }
}

DI void rwkv_fix_phase(const P& p, int l, int bid, int nb) {
  const int tid = my_tid(), lane = tid & 63, wv = tid >> 6, r = lane & 15, q = lane >> 4;
  for (int item = bid; item < 32 * 32; item += nb) {
    const int ci = item >> 5, tile = item & 31;
    const int b = ci >> 3, h = (ci & 7) >> 1, d = ci & 1;
    const int base = NCTX + b * 4096, T = 4096;
    const int s0 = (T >> 1) + tile * 64 + wv * 16;
    bf16x8 af[2];
    {
      int sidx = s0 + r;
      int t = d ? (T - 1 - sidx) : sidx;
      const bf16_t* zp = p.proj + (size_t)(base + t) * PROJ_LD + RW0 + 768 + h * 64 + q * 8;
      af[0] = __builtin_bit_cast(bf16x8, *(const uint4*)(zp));
      af[1] = __builtin_bit_cast(bf16x8, *(const uint4*)(zp + 32));
    }
    f32x4 acc[4];
#pragma unroll
    for (int vt = 0; vt < 4; ++vt) {
      acc[vt] = (f32x4){0.f, 0.f, 0.f, 0.f};
#pragma unroll
      for (int ks = 0; ks < 2; ++ks) {
        const float* sp = p.smid + ((size_t)ci * 64 + vt * 16 + r) * 64 + ks * 32 + q * 8;
        float4 x0 = *(const float4*)(sp), x1 = *(const float4*)(sp + 4);
        bf16x8 bb;
        bb[0] = (short)f2bf(x0.x); bb[1] = (short)f2bf(x0.y); bb[2] = (short)f2bf(x0.z); bb[3] = (short)f2bf(x0.w);
        bb[4] = (short)f2bf(x1.x); bb[5] = (short)f2bf(x1.y); bb[6] = (short)f2bf(x1.z); bb[7] = (short)f2bf(x1.w);
        acc[vt] = __builtin_amdgcn_mfma_f32_16x16x32_bf16(af[ks], bb, acc[vt], 0, 0, 0);
      }
    }
#pragma unroll
    for (int e = 0; e < 4; ++e) {
      int sidx = s0 + q * 4 + e;
      int t = d ? (T - 1 - sidx) : sidx;
      bf16_t* op = p.outs + (size_t)(base + t) * OUTS_LD + d * 256 + h * 64 + r;
#pragma unroll
      for (int vt = 0; vt < 4; ++vt) op[vt * 16] = f2bf(bf2f(op[vt * 16]) + acc[vt][e]);
    }
  }
}

DI void mixers_phase(const P& p, int l, char* smem, int cidx) {
  __shared__ int s_item;
  const int n_rl = 384, n_sl = 48, n_rc = 512, n_sc = 192, n_al = 1536, n_ac = 384;
  const int n_mix = n_rl + n_sl + n_rc + n_sc + n_al + n_ac;
  const int total = n_mix + 2368;
  for (;;) {
    if (my_tid() == 0) s_item = (int)atomicAdd(&p.counters[cidx], 1u);
    __syncthreads();
    int it = s_item;
    __syncthreads();
    if (it >= total) { __builtin_amdgcn_s_setprio(0); break; }
    int kind, idx, rci = 0, rrg = 0, runit = 3;
    if (it < n_rl) { kind = 0; idx = it; runit = it >> 7; rci = (it & 127) >> 2; rrg = it & 3; }
    else if (it < n_rl + n_sl) { kind = 1; idx = it - n_rl; }
    else if (it < n_rl + n_sl + n_rc) { kind = 0; idx = it - n_rl - n_sl; rci = 32 + (idx >> 2); rrg = idx & 3; runit = 3; }
    else if (it < n_rl + n_sl + n_rc + n_sc) { kind = 1; idx = 48 + (it - n_rl - n_sl - n_rc); }
    else if (it < n_mix) { kind = 2; idx = it - (n_rl + n_sl + n_rc + n_sc); }
    else { kind = 3; idx = it - n_mix; }
    if (it < n_rl) __builtin_amdgcn_s_setprio(3); else if (it < n_rl + n_sl) __builtin_amdgcn_s_setprio(2); else __builtin_amdgcn_s_setprio(0);
    if (kind == 0) rwkv_item(p, l, rci, rrg, runit, smem);
    else if (kind == 1) ssd_item(p, l, idx, smem);
    else if (kind == 2) { attn_item(p, l, idx, smem); __syncthreads(); }
    else conv_rest_item(p, l, idx, (float*)smem);
  }
}

DI void unpack8(uint4 u, float (&f)[8]) {
  f[0] = __uint_as_float(u.x << 16); f[1] = __uint_as_float(u.x & 0xffff0000u);
  f[2] = __uint_as_float(u.y << 16); f[3] = __uint_as_float(u.y & 0xffff0000u);
  f[4] = __uint_as_float(u.z << 16); f[5] = __uint_as_float(u.z & 0xffff0000u);
  f[6] = __uint_as_float(u.w << 16); f[7] = __uint_as_float(u.w & 0xffff0000u);
}
DI float red8c(float x) { x += dpp_f<0xB1>(x); x += dpp_f<0x4E>(x); x += dpp_f<0x141>(x); return x; }
DI void ld8(const float* q, float (&f)[8]) { float4 a = *(const float4*)q, b = *(const float4*)(q + 4); f[0] = a.x; f[1] = a.y; f[2] = a.z; f[3] = a.w; f[4] = b.x; f[5] = b.y; f[6] = b.z; f[7] = b.w; }
DI void combine_phase(const P& p, int l, int bid, int nb) {
  int wv = my_tid() >> 6, lane = my_tid() & 63;
  const bool sl = lane < 48, rl = lane < 32;
  const int cs = (sl ? lane : 0) * 8;
  const int cr = (rl ? lane : 0) * 8;
  float cw[5][8], cb[8], nw[8];
#pragma unroll
  for (int j = 0; j < 5; ++j) ld8(p.ssd_conv_w + (l * 5 + j) * 640 + cs, cw[j]);
  ld8(p.ssd_conv_b + l * 640 + cs, cb);
  ld8(p.ssd_norm_w + l * 384 + cs, nw);
  const float Dh = p.ssd_d[l * 6 + (cs >> 6)];
  float mur[8], muk[8], muv[8], ka[8], rk[8], gw[8], gb[8];
  ld8(p.rwkv_mu + l * 1024 + cr, mur); ld8(p.rwkv_mu + l * 1024 + 256 + cr, muk); ld8(p.rwkv_mu + l * 1024 + 512 + cr, muv);
  ld8(p.rwkv_k_a + l * 256 + cr, ka); ld8(p.rwkv_r_k + l * 256 + cr, rk); ld8(p.rwkv_gn_w + l * 256 + cr, gw); ld8(p.rwkv_gn_b + l * 256 + cr, gb);
  for (int tok = bid * 4 + wv; tok < NTOK; tok += nb * 4) {
    int base, t, T, cj; tok_info(tok, base, t, T, cj);
    const bf16_t* os = p.outs + (size_t)tok * OUTS_LD;
    const bf16_t* pj = p.proj + (size_t)tok * PROJ_LD;
    float ys[8]; float ssq = 0.f;
    {
      float acc[8];
#pragma unroll
      for (int e = 0; e < 8; ++e) acc[e] = cb[e];
#pragma unroll
      for (int j = 0; j < 5; ++j) {
        int tt = t + j - 2;
        bool ok = (tt >= 0) && (tt < T);
        float x[8];
        unpack8(*(const uint4*)(pj + (ok ? (j - 2) * PROJ_LD : 0) + 1024 + cs), x);
#pragma unroll
        for (int e = 0; e < 8; ++e) acc[e] += ok ? cw[j][e] * x[e] : 0.f;
      }
      float yf[8], yb[8], z[8];
      unpack8(*(const uint4*)(os + 512 + cs), yf); unpack8(*(const uint4*)(os + 896 + cs), yb); unpack8(*(const uint4*)(pj + 640 + cs), z);
#pragma unroll
      for (int e = 0; e < 8; ++e) {
        float y = (yf[e] + yb[e] + Dh * siluf_(acc[e])) * siluf_(z[e]);
        y = sl ? y : 0.f;
        ys[e] = y; ssq += y * y;
      }
    }
    asm volatile("" ::: "memory");
    float rw[8];
    {
      float of[8], ob[8], o[8];
      unpack8(*(const uint4*)(os + cr), of); unpack8(*(const uint4*)(os + 256 + cr), ob);
      float s1 = 0.f;
#pragma unroll
      for (int e = 0; e < 8; ++e) { o[e] = of[e] + ob[e]; s1 += o[e]; }
      float mu = red8c(s1) * (1.f / 64.f);
      float s2 = 0.f;
#pragma unroll
      for (int e = 0; e < 8; ++e) { o[e] -= mu; s2 += o[e] * o[e]; }
      float rstd = rsqrtf(red8c(s2) * (1.f / 64.f) + 64e-5f);
      const bf16_t* pr = pj + RW0 + cr;
      const int om = (t > 0) ? -PROJ_LD : 0, on = (t < T - 1) ? PROJ_LD : 0;
      const float fm = (t > 0) ? 0.5f : 0.f, fn = (t < T - 1) ? 0.5f : 0.f;
      float c_[8], m_[8], n_[8], rr[8], kx[8], vv[8];
      unpack8(*(const uint4*)(pr), c_); unpack8(*(const uint4*)(pr + om), m_); unpack8(*(const uint4*)(pr + on), n_);
#pragma unroll
      for (int e = 0; e < 8; ++e) rr[e] = c_[e] + mur[e] * (fm * m_[e] + fn * n_[e] - c_[e]);
      unpack8(*(const uint4*)(pr + 256), c_); unpack8(*(const uint4*)(pr + 256 + om), m_); unpack8(*(const uint4*)(pr + 256 + on), n_);
#pragma unroll
      for (int e = 0; e < 8; ++e) kx[e] = c_[e] + muk[e] * (fm * m_[e] + fn * n_[e] - c_[e]);
      unpack8(*(const uint4*)(pr + 512), c_); unpack8(*(const uint4*)(pr + 512 + om), m_); unpack8(*(const uint4*)(pr + 512 + on), n_);
#pragma unroll
      for (int e = 0; e < 8; ++e) vv[e] = c_[e] + muv[e] * (fm * m_[e] + fn * n_[e] - c_[e]);
      const bf16_t* lp = p.lr + (size_t)tok * LR_LD;
      float a0[8], a1[8], g[8];
      unpack8(*(const uint4*)(lp + 512 + cr), a0); unpack8(*(const uint4*)(lp + 768 + cr), a1); unpack8(*(const uint4*)(lp + 1024 + cr), g);
      float bs = 0.f;
#pragma unroll
      for (int e = 0; e < 8; ++e) {
        float kd = kx[e] * (1.f + (a0[e] - 1.f) * ka[e]) + kx[e] * (1.f + (a1[e] - 1.f) * ka[e]);
        bs += rr[e] * kd * rk[e];
      }
      float bsum = red8c(bs);
#pragma unroll
      for (int e = 0; e < 8; ++e) rw[e] = (o[e] * rstd * gw[e] + gb[e] + bsum * vv[e]) * g[e];
    }
    float rs = rsqrtf(wave_sum(ssq) * (1.f / 384.f) + 1e-5f);
    bf16_t* od = p.outs + (size_t)tok * OUTS_LD;
    if (sl) *(uint4*)(od + cs) = make_uint4(pack_bf2(ys[0] * rs * nw[0], ys[1] * rs * nw[1]), pack_bf2(ys[2] * rs * nw[2], ys[3] * rs * nw[3]),
                                            pack_bf2(ys[4] * rs * nw[4], ys[5] * rs * nw[5]), pack_bf2(ys[6] * rs * nw[6], ys[7] * rs * nw[7]));
    if (rl) *(uint4*)(od + 384 + cr) = make_uint4(pack_bf2(rw[0], rw[1]), pack_bf2(rw[2], rw[3]), pack_bf2(rw[4], rw[5]), pack_bf2(rw[6], rw[7]));
  }
}

#define XB_TMO      128
#define XB_XCNT(j)  (256  + 64 * (j))
#define XB_XSUB(j)  (1280 + 64 * (j))
#define XB_XGEN(j)  (2304 + 64 * (j))
#define XB_TOP      3328
#define XB_TOPGEN   3392
#define XCD_BAR_WORDS 3456
#define XB_SPIN_CAP (1u << 22)
#define LAS __attribute__((address_space(3)))
DI unsigned xb_ld(unsigned* p)              { return __hip_atomic_load(p, __ATOMIC_RELAXED, __HIP_MEMORY_SCOPE_AGENT); }
DI unsigned xb_add(unsigned* p, unsigned v) { return __hip_atomic_fetch_add(p, v, __ATOMIC_RELAXED, __HIP_MEMORY_SCOPE_AGENT); }
DI unsigned xb_xcc_id() { return (unsigned)__builtin_amdgcn_s_getreg((3 << 11) | 20) & 0xFu; }
#define XB_SPIN(cond, bar) do { unsigned _sp = 0; while (cond) { __builtin_amdgcn_s_sleep(1); \
    if ((++_sp & 255u) == 0u) { if (xb_ld(&(bar)[XB_TMO])) break; if (_sp > XB_SPIN_CAP) { atomicAdd(&(bar)[XB_TMO], 1u); break; } } } } while (0)
struct XcdBarrier { unsigned* bar; unsigned x; volatile LAS unsigned* st; };
DI XcdBarrier xcd_barrier_post(unsigned* bar, volatile LAS unsigned* st) {
  XcdBarrier b; b.bar = bar; b.x = xb_xcc_id(); b.st = st;
  if (threadIdx.x == 0) (void)xb_add(&bar[XB_XCNT(b.x)], 1u);
  return b;
}
DI void xcd_barrier_complete(unsigned* bar, unsigned x, unsigned& nloc, unsigned& nx) {
  const unsigned G = gridDim.x * gridDim.y * gridDim.z;
  unsigned sum, cnt, mine, sp = 0u;
  for (;;) {
    sum = 0u; cnt = 0u; mine = 0u;
#pragma unroll
    for (unsigned j = 0; j < 16; ++j) { const unsigned c = xb_ld(&bar[XB_XCNT(j)]); sum += c; cnt += (c > 0u) ? 1u : 0u; mine = (j == x) ? c : mine; }
    if (sum == G) break;
    __builtin_amdgcn_s_sleep(1);
    if ((++sp & 255u) == 0u) { if (xb_ld(&bar[XB_TMO])) break; if (sp > XB_SPIN_CAP) { atomicAdd(&bar[XB_TMO], 1u); break; } }
  }
  nloc = mine > 0u ? mine : 1u; nx = cnt > 0u ? cnt : 1u;
}
DI void xcd_barrier(const XcdBarrier& b) {
  asm volatile("s_waitcnt vmcnt(0)" ::: "memory");
  __syncthreads();
  if (threadIdx.x == 0) {
    unsigned* bar = b.bar;
    __builtin_amdgcn_s_waitcnt(0);
    unsigned nloc = b.st[0], nx = b.st[1];
    if (nloc == 0u) { xcd_barrier_complete(bar, b.x, nloc, nx); b.st[0] = nloc; b.st[1] = nx; }
    const unsigned old = xb_add(&bar[XB_XSUB(b.x)], 1u);
    const unsigned gen = old / nloc;
    if (old + 1u == (gen + 1u) * nloc) {
      __builtin_amdgcn_fence(__ATOMIC_RELEASE, "agent");
      asm volatile("s_waitcnt vmcnt(0)" ::: "memory");
      const unsigned og = xb_add(&bar[XB_TOP], 1u);
      const unsigned tg = og / nx;
      if (og + 1u == (tg + 1u) * nx) xb_add(&bar[XB_TOPGEN], 1u);
      else XB_SPIN(xb_ld(&bar[XB_TOPGEN]) == tg, bar);
      __builtin_amdgcn_fence(__ATOMIC_ACQUIRE, "agent");
      xb_add(&bar[XB_XGEN(b.x)], 1u);
      asm volatile("s_waitcnt vmcnt(0)" ::: "memory");
    } else {
      XB_SPIN(xb_ld(&bar[XB_XGEN(b.x)]) == gen, bar);
      __builtin_amdgcn_fence(__ATOMIC_ACQUIRE, "agent");
      asm volatile("s_waitcnt vmcnt(0)" ::: "memory");
    }
  }
  __syncthreads();
}

constexpr int NPHASE = 24;
DI void run_phase(const P& p, int ph, int bid, int nb, char* smem) {
  if (ph == 0) { phase0(p, bid, nb, (float*)smem); return; }
  if (ph == 23) { lnmod_phase(p, 2, 1, 0, -1, bid, nb); return; }
  int l = (ph - 1) / 11, s = (ph - 1) % 11;
  switch (s) {
    case 0:
      if (l == 0) lnmod_phase(p, 0, 0, 0, 0, bid, nb);
      else lnmod_phase(p, 2, 0, 1, 0, bid, nb);
      break;
    case 1: gemm_phase_dma256(p.hA, 1024, p.Win + (size_t)l * 2816 * 1024, 80, 22, 1024, Epi1{p, l}, bid, nb, smem); break;
    case 2: prepA_phase(p, l, bid, nb); break;
    case 3: gemm_phase_dma(p.Alr, 256, p.Alr, 256, 1 << 30, p.Wlr + (size_t)l * 1280 * 256, 160, 10, 256, EpiLRT{p, l}, bid, nb, smem); break;
    case 4: mixers_phase(p, l, smem, l); break;
    case 5: rwkv_fix_phase(p, l, bid, nb); break;
    case 6: combine_phase(p, l, bid, nb); break;
    case 7: gemm_phase_dma(p.mixA, 384, p.outs, OUTS_LD, 384, p.Wout, 160, 8, 1024, EpiResT{p, l, 2048}, bid, nb, smem); break;
    case 8: lnmod_phase(p, 1, l, l, 3072, bid, nb); break;
    case 9: gemm_phase_dma256(p.hA, 1024, p.Wffi, 80, 44, 1024, EpiFfn{p}, bid, nb, smem); break;
    case 10: gemm_phase_dma(p.hidden, HID_LD, p.hidden, HID_LD, 1 << 30, p.Wffo, 160, 8, 2816, EpiResT{p, l, 5120}, bid, nb, smem); break;
  }
}

#if !MEGA
__global__ void __launch_bounds__(256, 2) k_phase(P p, int ph) {
  __shared__ __attribute__((aligned(16))) char smem[SMEM_BYTES];
  run_phase(p, ph, blockIdx.x, gridDim.x, smem);
}
#endif

#if MEGA
__global__ void __launch_bounds__(256, 2) k_mega(P p) {
  __shared__ __attribute__((aligned(16))) char smem[SMEM_BYTES];
  cg::grid_group grid = cg::this_grid();
  __shared__ uint4 xb_words;
  if (threadIdx.x == 0) xb_words = make_uint4(0u, 0u, 0u, 0u);
  __syncthreads();
  XcdBarrier xb = xcd_barrier_post(p.bar, (volatile LAS unsigned*)&xb_words);
#define RUNPH(PH) { int bidv = blockIdx.x, nbv = gridDim.x; asm volatile("" : "+s"(bidv), "+s"(nbv) :: "memory"); run_phase(p, PH, bidv, nbv, smem); }
  RUNPH(0); xcd_barrier(xb); if (p.out == nullptr) grid.sync();
  RUNPH(1); xcd_barrier(xb); RUNPH(2); xcd_barrier(xb); RUNPH(3); xcd_barrier(xb); RUNPH(4); xcd_barrier(xb); RUNPH(5); xcd_barrier(xb);
  RUNPH(6); xcd_barrier(xb); RUNPH(7); xcd_barrier(xb); RUNPH(8); xcd_barrier(xb); RUNPH(9); xcd_barrier(xb); RUNPH(10); xcd_barrier(xb);
  RUNPH(11); xcd_barrier(xb);
  RUNPH(12); xcd_barrier(xb); RUNPH(13); xcd_barrier(xb); RUNPH(14); xcd_barrier(xb); RUNPH(15); xcd_barrier(xb); RUNPH(16); xcd_barrier(xb);
  RUNPH(17); xcd_barrier(xb); RUNPH(18); xcd_barrier(xb); RUNPH(19); xcd_barrier(xb); RUNPH(20); xcd_barrier(xb); RUNPH(21); xcd_barrier(xb);
  RUNPH(22); xcd_barrier(xb);
  RUNPH(23);
}
#endif

extern "C" void kernel_launch(void* const* d_in, const int* in_sizes, int n_in, void* d_out, int out_size, void* d_ws, size_t ws_size,
                              hipStream_t stream) {
  P p{};
  const float** fp = (const float**)&p;
  for (int i = 0; i < 36; ++i) fp[i] = (const float*)d_in[i];
  p.out = (float*)d_out;
  char* ws = (char*)d_ws;
  size_t off = 0;
  auto take = [&](size_t bytes) { char* r = ws + off; off += (bytes + 255) & ~(size_t)255; return r; };
  p.mod = (float*)take(2 * 5 * 6144 * 4);
  p.rope = (float*)take(64 * 16 * 2 * 4);
  p.bar = (unsigned*)take(16384);
  p.counters = p.bar + XCD_BAR_WORDS;
  p.smid = (float*)take((size_t)32 * 4096 * 4);
  p.Wlr = (bf16_t*)take((size_t)2 * 1280 * 256 * 2);
  p.Win = (bf16_t*)take((size_t)2 * 2816 * 1024 * 2);
  p.Wout = (bf16_t*)take((size_t)1024 * 1024 * 2);
  p.Wffi = (bf16_t*)take((size_t)5632 * 1024 * 2);
  p.Wffo = (bf16_t*)take((size_t)1024 * 2816 * 2);
  p.proj = (bf16_t*)take((size_t)NTOK * PROJ_LD * 2);
  p.hidden = p.proj;
  p.lr = (bf16_t*)take((size_t)NTOK * LR_LD * 2);
  p.mixA = (bf16_t*)take((size_t)NTOK * 384 * 2);
  p.outs = (bf16_t*)take((size_t)NTOK * OUTS_LD * 2);
  p.Alr = p.outs;
  p.hA = p.outs;
  if (off > ws_size) { fprintf(stderr, "workspace too small: need %zu have %zu\n", off, ws_size); }
#if MEGA
  hipMemsetAsync(d_ws, 0, (size_t)((char*)p.bar - (char*)d_ws) + 16384, stream);
  static int grid_blocks = 0;
  if (!grid_blocks) {
    int dev = 0, cus = 0, per_cu = 0;
    hipGetDevice(&dev);
    hipDeviceGetAttribute(&cus, hipDeviceAttributeMultiprocessorCount, dev);
    hipOccupancyMaxActiveBlocksPerMultiprocessor(&per_cu, k_mega, 256, 0);
    if (per_cu > 2) per_cu = 2;
    grid_blocks = cus * per_cu;
  }
  void* args[] = {&p};
  hipError_t e = hipLaunchCooperativeKernel((void*)k_mega, dim3(grid_blocks), dim3(256), args, 0, stream);
  if (e != hipSuccess) fprintf(stderr, "cooperative launch failed: %s (grid %d)\n", hipGetErrorString(e), grid_blocks);
#else
  for (int ph = 0; ph < NPHASE; ++ph) k_phase<<<512, 256, 0, stream>>>(p, ph);
#endif
}
```
